# Optimizing an MI355X kernel written in HIP

```python
import math
import jax, jax.numpy as jnp
from jax import lax
import numpy as np

D_MODEL = 1024
BATCH = 8
SEQ = 4096
DEPTH = 2

D_CONV = D_MODEL // 2
CONV_WIDTH = 3
D_SSM = D_MODEL // 2
SSM_GROUP_DIM = 16
SSM_GROUPS = D_SSM // SSM_GROUP_DIM
SSM_STATE = 64
SSM_DT_MIN = 1e-3
SSM_DT_MAX = 1e-1
MLA_HEADS = 8
QK_NOPE = 64
QK_ROPE = 32
V_HEAD = 64
Q_LORA = D_MODEL // 4
KV_LORA = D_MODEL // 8
D_ATTN = MLA_HEADS * V_HEAD
ROPE_THETA = 10000.0
Q_BLOCK = 128
N_BRANCHES = 3
IN_MIX = 3 * D_CONV + D_SSM + Q_LORA + KV_LORA + QK_ROPE
N_IN = IN_MIX + N_BRANCHES * D_MODEL
IN_SPLITS = (
    D_CONV,
    2 * D_CONV,
    3 * D_CONV,
    3 * D_CONV + D_SSM,
    3 * D_CONV + D_SSM + Q_LORA,
    3 * D_CONV + D_SSM + Q_LORA + KV_LORA,
    IN_MIX,
    IN_MIX + D_MODEL,
    IN_MIX + 2 * D_MODEL,
)
N_EXPERTS = 32
N_EXPERT_GROUPS = 8
EXPERTS_PER_GROUP = N_EXPERTS // N_EXPERT_GROUPS
TOPK_GROUPS = 1
TOP_K = 2
D_EXPERT = D_MODEL // 4
EXPERT_BLOCK = 128
DEEPNORM_ALPHA = (2 * DEPTH) ** 0.25
DEEPNORM_BETA = (8 * DEPTH) ** -0.25
LN_EPS = 1e-5
RMS_EPS = 1e-6

kernel_name = "hybrid_conv_s5_mla_grouped_moe_deepnorm_adaln"


def layer_norm_plain(x):
    xf = x.astype(jnp.float32)
    mu = jnp.mean(xf, axis=-1, keepdims=True)
    var = jnp.mean(jnp.square(xf - mu), axis=-1, keepdims=True)
    return ((xf - mu) * lax.rsqrt(var + LN_EPS)).astype(x.dtype)


def layer_norm(x, g, b):
    return (layer_norm_plain(x) * g + b).astype(x.dtype)


def rms_norm(x, g):
    xf = x.astype(jnp.float32)
    y = xf * lax.rsqrt(jnp.mean(jnp.square(xf), axis=-1, keepdims=True) + RMS_EPS)
    return (y * g).astype(x.dtype)


def modulate(x, shift, scale):
    return layer_norm_plain(x) * (1.0 + scale[:, None, :]) + shift[:, None, :]


def rope_tables(positions):
    inv_freq = ROPE_THETA ** (-jnp.arange(0, QK_ROPE, 2, dtype=jnp.float32) / QK_ROPE)
    ang = positions.astype(jnp.float32)[..., None] * inv_freq
    return jnp.cos(ang), jnp.sin(ang)


def apply_rope(x, cos, sin):
    x1, x2 = jnp.split(x, 2, axis=-1)
    cos = cos.astype(x.dtype)
    sin = sin.astype(x.dtype)
    return jnp.concatenate([x1 * cos - x2 * sin, x1 * sin + x2 * cos], axis=-1)


def short_conv_branch(xc, gc, gb, conv_w):
    u = gc * xc
    out = lax.conv_general_dilated(
        u, conv_w[:, None, :], window_strides=(1,),
        padding=[(CONV_WIDTH - 1, 0)],
        dimension_numbers=("NWC", "WIO", "NWC"),
        feature_group_count=D_CONV)
    return gb * out


def s5_branch(u, a_re, a_im, b_re, b_im, c_re, c_im, d_skip, log_dt, w_glu):
    Bsz, S, _ = u.shape
    f32 = jnp.float32
    uf = u.astype(f32).reshape(Bsz, S, SSM_GROUPS, SSM_GROUP_DIM)
    ar = a_re.astype(f32)
    ai = a_im.astype(f32)
    dt = jnp.exp(log_dt.astype(f32))[:, None]
    mag = jnp.exp(ar * dt)
    lb_re = mag * jnp.cos(ai * dt)
    lb_im = mag * jnp.sin(ai * dt)
    den = ar * ar + ai * ai
    nr = lb_re - 1.0
    ni = lb_im
    f_re = (nr * ar + ni * ai) / den
    f_im = (ni * ar - nr * ai) / den
    br = b_re.astype(f32)
    bi = b_im.astype(f32)
    bb_re = f_re[..., None] * br - f_im[..., None] * bi
    bb_im = f_re[..., None] * bi + f_im[..., None] * br
    bu_re = jnp.einsum("bsgp,gnp->bsgn", uf, bb_re)
    bu_im = jnp.einsum("bsgp,gnp->bsgn", uf, bb_im)
    la_re = jnp.broadcast_to(lb_re[None, None], (1, S, SSM_GROUPS, SSM_STATE))
    la_im = jnp.broadcast_to(lb_im[None, None], (1, S, SSM_GROUPS, SSM_STATE))

    def combine(e_i, e_j):
        ar_i, ai_i, br_i, bi_i = e_i
        ar_j, ai_j, br_j, bi_j = e_j
        return (ar_j * ar_i - ai_j * ai_i,
                ar_j * ai_i + ai_j * ar_i,
                ar_j * br_i - ai_j * bi_i + br_j,
                ar_j * bi_i + ai_j * br_i + bi_j)

    _, _, s_re, s_im = lax.associative_scan(combine, (la_re, la_im, bu_re, bu_im), axis=1)
    y = (jnp.einsum("bsgn,gpn->bsgp", s_re, c_re.astype(f32))
         - jnp.einsum("bsgn,gpn->bsgp", s_im, c_im.astype(f32))
         + d_skip.astype(f32).reshape(SSM_GROUPS, SSM_GROUP_DIM) * uf)
    y = jax.nn.gelu(y.reshape(Bsz, S, D_SSM))
    val, gate = jnp.split(y @ w_glu.astype(f32), 2, axis=-1)
    return (val * jax.nn.sigmoid(gate)).astype(u.dtype)


def causal_block_attention(q, k, v):
    Bsz, S, H, Dk = q.shape
    nb = S // Q_BLOCK
    qb = q.reshape(Bsz, nb, Q_BLOCK, H, Dk).transpose(1, 0, 2, 3, 4)
    key_idx = jnp.arange(S, dtype=jnp.int32)
    scale = Dk ** -0.5

    def one_block(args):
        qi, bi = args
        s = jnp.einsum("bqhd,bkhd->bhqk", qi, k, preferred_element_type=jnp.float32) * scale
        q_idx = bi * Q_BLOCK + jnp.arange(Q_BLOCK, dtype=jnp.int32)
        mask = key_idx[None, :] <= q_idx[:, None]
        s = jnp.where(mask[None, None], s, -jnp.inf)
        p = jax.nn.softmax(s, axis=-1).astype(v.dtype)
        return jnp.einsum("bhqk,bkhd->bqhd", p, v)

    o = lax.map(one_block, (qb, jnp.arange(nb, dtype=jnp.int32)))
    return o.transpose(1, 0, 2, 3, 4).reshape(Bsz, S, H * v.shape[-1])


def mla_branch(c_q, c_kv, k_r, cos, sin, q_norm, w_uq, kv_norm, w_uk, w_uv):
    Bsz, S, _ = c_q.shape
    cq = rms_norm(c_q, q_norm)
    ckv = rms_norm(c_kv, kv_norm)
    q = (cq @ w_uq).reshape(Bsz, S, MLA_HEADS, QK_NOPE + QK_ROPE)
    q_rope = apply_rope(q[..., QK_NOPE:], cos[:, :, None, :], sin[:, :, None, :])
    q = jnp.concatenate([q[..., :QK_NOPE], q_rope], axis=-1)
    k_rope = apply_rope(k_r, cos, sin)
    k_nope = (ckv @ w_uk).reshape(Bsz, S, MLA_HEADS, QK_NOPE)
    v = (ckv @ w_uv).reshape(Bsz, S, MLA_HEADS, V_HEAD)
    k = jnp.concatenate(
        [k_nope, jnp.broadcast_to(k_rope[:, :, None, :], (Bsz, S, MLA_HEADS, QK_ROPE))], axis=-1)
    return causal_block_attention(q, k, v)


def hybrid_mixer(h, cos, sin, w_in, conv_w, a_re, a_im, b_re, b_im, c_re, c_im, d_skip,
                 log_dt, w_glu, q_norm, w_uq, kv_norm, w_uk, w_uv,
                 w_up_conv, w_up_ssm, w_up_attn, w_o):
    proj = h @ w_in
    (xc, gc, gb, u_ssm, c_q, c_kv, k_r,
     g_conv, g_ssm, g_attn) = jnp.split(proj, IN_SPLITS, axis=-1)
    y_conv = short_conv_branch(xc, gc, gb, conv_w) @ w_up_conv
    y_ssm = s5_branch(u_ssm, a_re, a_im, b_re, b_im, c_re, c_im, d_skip, log_dt, w_glu) @ w_up_ssm
    y_attn = mla_branch(c_q, c_kv, k_r, cos, sin, q_norm, w_uq, kv_norm, w_uk, w_uv) @ w_up_attn
    merged = (jax.nn.sigmoid(g_conv) * y_conv
              + jax.nn.sigmoid(g_ssm) * y_ssm
              + jax.nn.sigmoid(g_attn) * y_attn)
    return merged @ w_o


def swiglu(x, w1, w3, w2):
    return (jax.nn.silu(x @ w1) * (x @ w3)) @ w2


def grouped_top2_route(h2d, router_w, router_bias):
    T = h2d.shape[0]
    s = jax.nn.sigmoid(h2d.astype(jnp.float32) @ router_w.astype(jnp.float32))
    sel = s + router_bias.astype(jnp.float32)
    grp = sel.reshape(T, N_EXPERT_GROUPS, EXPERTS_PER_GROUP)
    grp_score = lax.top_k(grp, 2)[0].sum(axis=-1)
    _, g_idx = lax.top_k(grp_score, TOPK_GROUPS)
    g_mask = jnp.any(g_idx[:, :, None] == jnp.arange(N_EXPERT_GROUPS)[None, None, :], axis=1)
    e_mask = jnp.repeat(g_mask, EXPERTS_PER_GROUP, axis=1)
    _, e_idx = lax.top_k(jnp.where(e_mask, sel, -jnp.inf), TOP_K)
    w = jnp.take_along_axis(s, e_idx, axis=1)
    w = w / jnp.sum(w, axis=-1, keepdims=True)
    return e_idx, w


def routed_experts(h2d, e_idx, e_w, w1, w3, w2):
    T, D = h2d.shape
    M = T * TOP_K
    flat_e = e_idx.reshape(M)
    flat_tok = jnp.arange(M, dtype=jnp.int32) // TOP_K
    flat_w = e_w.reshape(M)
    order = jnp.argsort(flat_e)
    e_sorted = flat_e[order]
    tok_sorted = flat_tok[order]
    w_sorted = flat_w[order]
    counts = jnp.bincount(flat_e, length=N_EXPERTS)
    padded = (counts + EXPERT_BLOCK - 1) // EXPERT_BLOCK * EXPERT_BLOCK
    pad_end = jnp.cumsum(padded)
    pad_start = pad_end - padded
    start = jnp.cumsum(counts) - counts
    dest = pad_start[e_sorted] + (jnp.arange(M, dtype=jnp.int32) - start[e_sorted])
    n_blocks = (M + EXPERT_BLOCK - 1) // EXPERT_BLOCK + N_EXPERTS
    n_rows = n_blocks * EXPERT_BLOCK
    row_tok = jnp.zeros((n_rows,), jnp.int32).at[dest].set(tok_sorted)
    row_w = jnp.zeros((n_rows,), h2d.dtype).at[dest].set(w_sorted)
    block_starts = jnp.arange(n_blocks, dtype=pad_end.dtype) * EXPERT_BLOCK
    block_e = jnp.minimum(jnp.searchsorted(pad_end, block_starts, side="right"), N_EXPERTS - 1)
    x_rows = h2d[row_tok].reshape(n_blocks, EXPERT_BLOCK, D)

    def one_block(args):
        xb, e = args
        return swiglu(xb, w1[e], w3[e], w2[e])

    y_rows = lax.map(one_block, (x_rows, block_e)).reshape(n_rows, D)
    return jax.ops.segment_sum(y_rows * row_w[:, None], row_tok, num_segments=T)


def moe_ffn(h, router_w, router_bias, w1, w3, w2, ws1, ws3, ws2):
    Bsz, S, D = h.shape
    h2d = h.reshape(Bsz * S, D)
    e_idx, e_w = grouped_top2_route(h2d, router_w, router_bias)
    y = routed_experts(h2d, e_idx, e_w.astype(h.dtype), w1, w3, w2) + swiglu(h2d, ws1, ws3, ws2)
    return y.reshape(Bsz, S, D)


def setup_inputs(seed: int = 0) -> dict:
    key = jax.random.key(seed)
    ks = iter(jax.random.split(key, 64))
    L = DEPTH
    beta = DEEPNORM_BETA

    def nrm(shape, scale):
        return scale * jax.random.normal(next(ks), shape, jnp.float32)

    x = nrm((BATCH, SEQ, D_MODEL), 1.0)
    c = nrm((BATCH, D_MODEL), 1.0)
    offset = jax.random.randint(next(ks), (BATCH, 1), 0, 2048, dtype=jnp.int32)
    positions = offset + jnp.arange(SEQ, dtype=jnp.int32)[None, :]
    n_idx = jnp.arange(SSM_STATE, dtype=jnp.float32)
    return {
        "x": x,
        "c": c,
        "positions": positions,
        "w_ada": nrm((L, D_MODEL, 6 * D_MODEL), 0.5 * D_MODEL ** -0.5),
        "b_ada": nrm((L, 6 * D_MODEL), 0.01),
        "w_in": nrm((L, D_MODEL, N_IN), D_MODEL ** -0.5),
        "conv_w": nrm((L, CONV_WIDTH, D_CONV), CONV_WIDTH ** -0.5),
        "ssm_a_re": -0.5 + nrm((L, SSM_GROUPS, SSM_STATE), 0.01),
        "ssm_a_im": math.pi * n_idx + nrm((L, SSM_GROUPS, SSM_STATE), 0.01),
        "ssm_b_re": nrm((L, SSM_GROUPS, SSM_STATE, SSM_GROUP_DIM), (2 * SSM_GROUP_DIM) ** -0.5),
        "ssm_b_im": nrm((L, SSM_GROUPS, SSM_STATE, SSM_GROUP_DIM), (2 * SSM_GROUP_DIM) ** -0.5),
        "ssm_c_re": nrm((L, SSM_GROUPS, SSM_GROUP_DIM, SSM_STATE), (2 * SSM_STATE) ** -0.5),
        "ssm_c_im": nrm((L, SSM_GROUPS, SSM_GROUP_DIM, SSM_STATE), (2 * SSM_STATE) ** -0.5),
        "ssm_d": nrm((L, D_SSM), 1.0),
        "ssm_log_dt": jax.random.uniform(next(ks), (L, SSM_GROUPS), jnp.float32,
                                         math.log(SSM_DT_MIN), math.log(SSM_DT_MAX)),
        "ssm_w_glu": nrm((L, D_SSM, 2 * D_SSM), D_SSM ** -0.5),
        "q_norm": 1.0 + nrm((L, Q_LORA), 0.01),
        "w_uq": nrm((L, Q_LORA, MLA_HEADS * (QK_NOPE + QK_ROPE)), Q_LORA ** -0.5),
        "kv_norm": 1.0 + nrm((L, KV_LORA), 0.01),
        "w_uk": nrm((L, KV_LORA, MLA_HEADS * QK_NOPE), KV_LORA ** -0.5),
        "w_uv": nrm((L, KV_LORA, MLA_HEADS * V_HEAD), beta * KV_LORA ** -0.5),
        "w_up_conv": nrm((L, D_CONV, D_MODEL), beta * D_CONV ** -0.5),
        "w_up_ssm": nrm((L, D_SSM, D_MODEL), beta * D_SSM ** -0.5),
        "w_up_attn": nrm((L, D_ATTN, D_MODEL), beta * D_ATTN ** -0.5),
        "w_o": nrm((L, D_MODEL, D_MODEL), beta * D_MODEL ** -0.5),
        "ln_g": 1.0 + nrm((L, 2, D_MODEL), 0.01),
        "ln_b": nrm((L, 2, D_MODEL), 0.01),
        "router_w": nrm((D_MODEL, N_EXPERTS), D_MODEL ** -0.5),
        "router_bias": nrm((N_EXPERTS,), 0.01),
        "exp_w1": nrm((L, N_EXPERTS, D_MODEL, D_EXPERT), D_MODEL ** -0.5),
        "exp_w3": nrm((L, N_EXPERTS, D_MODEL, D_EXPERT), D_MODEL ** -0.5),
        "exp_w2": nrm((L, N_EXPERTS, D_EXPERT, D_MODEL), beta * D_EXPERT ** -0.5),
        "shared_w1": nrm((L, D_MODEL, D_EXPERT), D_MODEL ** -0.5),
        "shared_w3": nrm((L, D_MODEL, D_EXPERT), D_MODEL ** -0.5),
        "shared_w2": nrm((L, D_EXPERT, D_MODEL), beta * D_EXPERT ** -0.5),
    }


def reference(x, c, positions, w_ada, b_ada, w_in, conv_w, ssm_a_re, ssm_a_im, ssm_b_re,
              ssm_b_im, ssm_c_re, ssm_c_im, ssm_d, ssm_log_dt, ssm_w_glu, q_norm, w_uq,
              kv_norm, w_uk, w_uv, w_up_conv, w_up_ssm, w_up_attn, w_o, ln_g, ln_b,
              router_w, router_bias, exp_w1, exp_w3, exp_w2, shared_w1, shared_w3, shared_w2):
    cos, sin = rope_tables(positions)
    cond = jax.nn.silu(c)
    for l in range(DEPTH):
        ada = cond @ w_ada[l] + b_ada[l]
        sh1, sc1, g1, sh2, sc2, g2 = jnp.split(ada, 6, axis=-1)
        h = modulate(x, sh1, sc1)
        y = hybrid_mixer(h, cos, sin, w_in[l], conv_w[l], ssm_a_re[l], ssm_a_im[l],
                         ssm_b_re[l], ssm_b_im[l], ssm_c_re[l], ssm_c_im[l], ssm_d[l],
                         ssm_log_dt[l], ssm_w_glu[l], q_norm[l], w_uq[l], kv_norm[l],
                         w_uk[l], w_uv[l], w_up_conv[l], w_up_ssm[l], w_up_attn[l], w_o[l])
        x = layer_norm(DEEPNORM_ALPHA * x + g1[:, None, :] * y, ln_g[l, 0], ln_b[l, 0])
        h = modulate(x, sh2, sc2)
        y = moe_ffn(h, router_w, router_bias, exp_w1[l], exp_w3[l], exp_w2[l],
                    shared_w1[l], shared_w3[l], shared_w2[l])
        x = layer_norm(DEEPNORM_ALPHA * x + g2[:, None, :] * y, ln_g[l, 1], ln_b[l, 1])
    return x
```

```cpp
#include <hip/hip_runtime.h>
#include <hip/hip_cooperative_groups.h>
#include <cstdio>
#include <cstdint>
namespace cg = cooperative_groups;

typedef unsigned short bf16_t;
typedef short bf16x8 __attribute__((ext_vector_type(8)));
typedef float f32x4 __attribute__((ext_vector_type(4)));
typedef float f32x16 __attribute__((ext_vector_type(16)));
typedef unsigned u32x4 __attribute__((ext_vector_type(4)));
typedef unsigned u32x2 __attribute__((ext_vector_type(2)));
#define LAS __attribute__((address_space(3)))
#define GAS __attribute__((address_space(1)))
#define DEV __device__ __forceinline__

constexpr int T_ = 32768, D_ = 1024, S_ = 4096, NB_ = 8, NH_ = 8, NL_ = 2;
constexpr int NIN_ = 5536, NMIX_ = 2464;
constexpr float ALPHA_ = 1.41421356237f;
constexpr float QSCALE_ = 0.10206207261596577f * 1.4426950408889634f;

constexpr size_t MiB = 1u << 20;
constexpr size_t OFF_CTRL = 0;
constexpr size_t OFF_ADA = 64 * 1024;
constexpr size_t OFF_ROUTE = 512 * 1024;
constexpr size_t OFF_RW = 768 * 1024;
constexpr size_t OFF_CS = 1 * MiB;
constexpr size_t OFF_LIST = 5 * MiB;
constexpr size_t OFF_LAML = 9 * MiB;
constexpr size_t OFF_WR = 9 * MiB + 512 * 1024;
constexpr size_t OFF_W = 10 * MiB;
constexpr size_t W_IN = 0;
constexpr size_t W_G = W_IN + 2560 * 1024 * 2;
constexpr size_t W_GLU = W_G + 3072 * 1024 * 2;
constexpr size_t W_UQ = W_GLU + 1024 * 512 * 2;
constexpr size_t W_UK = W_UQ + 1024 * 256 * 2;
constexpr size_t W_UV = W_UK + 512 * 128 * 2;
constexpr size_t W_UPC = W_UV + 512 * 128 * 2;
constexpr size_t W_UPS = W_UPC + 1024 * 512 * 2;
constexpr size_t W_UPA = W_UPS + 1024 * 512 * 2;
constexpr size_t W_O = W_UPA + 1024 * 512 * 2;
constexpr size_t W_S13 = W_O + 1024 * 1024 * 2;
constexpr size_t W_S2 = W_S13 + 512 * 1024 * 2;
constexpr size_t W_LAYER = W_S2 + 1024 * 256 * 2;
constexpr size_t OFF_LATE = OFF_W + 2 * W_LAYER + (MiB - (2 * W_LAYER) % MiB) % MiB;
constexpr size_t OFF_E13 = OFF_LATE;
constexpr size_t OFF_E2 = OFF_E13 + 32 * MiB;
constexpr size_t OFF_SBT = OFF_E2 + 16 * MiB;
constexpr size_t OFF_SG = OFF_SBT + 24 * MiB;
constexpr size_t OFF_H = OFF_SG + 4 * MiB;
constexpr size_t OFF_ACT = OFF_H + 64 * MiB;
constexpr size_t OFF_XC = OFF_ACT;
constexpr size_t OFF_GC = OFF_XC + 32 * MiB;
constexpr size_t OFF_GB = OFF_GC + 32 * MiB;
constexpr size_t OFF_USSM = OFF_GB + 32 * MiB;
constexpr size_t OFF_CQ = OFF_USSM + 32 * MiB;
constexpr size_t OFF_CKV = OFF_CQ + 16 * MiB;
constexpr size_t OFF_KR = OFF_CKV + 8 * MiB;
constexpr size_t OFF_Q = OFF_KR + 2 * MiB;
constexpr size_t OFF_KN = OFF_Q + 48 * MiB;
constexpr size_t OFF_KRP = OFF_KN + 32 * MiB;
constexpr size_t OFF_VT = OFF_KN + 48 * MiB;
constexpr size_t OFF_E = OFF_VT + 32 * MiB;
constexpr size_t OFF_SPREV = OFF_E + 16 * MiB;
constexpr size_t OFF_END = OFF_SPREV + 16 * MiB;
constexpr size_t OFF_ROUT = OFF_ACT;
constexpr size_t OFF_SHOUT = OFF_ROUT + 128 * MiB;
constexpr size_t OFF_MIDR = OFF_SHOUT + 64 * MiB;
constexpr size_t OFF_MIDS = OFF_MIDR + 34 * MiB;
static_assert(OFF_MIDS + 16 * MiB <= OFF_END, "moe alias");
static_assert(OFF_END <= 512 * MiB, "ws");
constexpr size_t OFF_MERGED = OFF_Q;

constexpr int CW_QUEUE = 0;
constexpr int CW_CNT = 4096;
constexpr int CTRL_WORDS = 8192;

constexpr int LDS_WORK = 65536;
constexpr int LDS_BYTES = LDS_WORK + 1024;

struct Params { const void* in[35]; float* out; char* ws; };
#define CAS __attribute__((address_space(4)))
struct KA {
    const CAS char* k;
    __device__ __forceinline__ const void* in(int i) const { return *(const void* const CAS*)(k + 8 * i); }
    __device__ __forceinline__ float* out() const { return *(float* const CAS*)(k + 8 * 35); }
    __device__ __forceinline__ char* ws() const { return *(char* const CAS*)(k + 8 * 36); }
};
__device__ __forceinline__ KA get_ka() { const CAS char* k = (const CAS char*)__builtin_amdgcn_kernarg_segment_ptr(); asm volatile("" : "+s"(k)); KA a; a.k = k; return a; }
__device__ __forceinline__ int tidx() { int t = threadIdx.x; asm volatile("" : "+v"(t)); return t; }

typedef float f32x2_t __attribute__((ext_vector_type(2)));
typedef __bf16 bf16x2_t __attribute__((ext_vector_type(2)));
DEV unsigned pk2(float lo, float hi) { const f32x2_t v = {lo, hi}; const bf16x2_t b = __builtin_convertvector(v, bf16x2_t); return __builtin_bit_cast(unsigned, b); }
DEV float bflo(unsigned w) { return __uint_as_float(w << 16); }
DEV float bfhi(unsigned w) { return __uint_as_float(w & 0xffff0000u); }
DEV float bf2f(bf16_t v) { return __uint_as_float((unsigned)v << 16); }
DEV bf16_t f2bf(float f) { return (bf16_t)(pk2(f, 0.f) & 0xffffu); }
DEV float sigmoidf_(float x) { return 1.f / (1.f + __expf(-x)); }
DEV float siluf_(float x) { return x * sigmoidf_(x); }
DEV float gelu_tanh(float y) { const float z = 0.7978845608028654f * (y + 0.044715f * y * y * y); const float t = 1.f - 2.f / (1.f + __expf(2.f * z)); return 0.5f * y * (1.f + t); }
DEV float wave_sum(float v) {
#pragma unroll
    for (int o = 1; o < 64; o <<= 1) v += __shfl_xor(v, o);
    return v;
}
DEV int next_item(unsigned* counter, LAS int* slot) {
    __syncthreads();
    if (threadIdx.x == 0) *slot = (int)atomicAdd(counter, 1u);
    __syncthreads();
    return *slot;
}

template <int N> struct RowsF {
    const char* base; unsigned off[N];
    DEV const char* operator()(int step, int i) const { return base + (off[i] + (unsigned)step * 128u); }
};
template <int N> struct RowsWrapF {
    const char* base; unsigned off[N];
    DEV const char* operator()(int step, int i) const { return base + (off[i] + (unsigned)(step & 15) * 128u); }
};
DEV int stage_row(int tid) { return tid >> 3; }
DEV int stage_q(int tid) { return (tid & 7) ^ ((tid >> 4) & 7); }
template <int N> DEV RowsF<N> mk_rows(const void* base, unsigned pitch_bytes, int row0) {
    RowsF<N> f; const int _t = tidx(); const int r = stage_row(_t), q = stage_q(_t);
    f.base = (const char*)base + (size_t)row0 * pitch_bytes;
#pragma unroll
    for (int i = 0; i < N; ++i) f.off[i] = (unsigned)(r + 32 * i) * pitch_bytes + q * 16;
    return f;
}

template <int BM, class AF, class BF>
DEV void gemm_core(f32x4 (&acc)[BM / 32][4], const int nsteps, const AF& af, const BF& bf, LAS char* lds) {
    constexpr int MI = BM / 32, NA = BM / 32, STAGE = BM * 128 + 16384;
    const int tid = tidx(), lane = tid & 63, wid = tid >> 6, wr = wid >> 1, wc = wid & 1, fr = lane & 15, fq = lane >> 4;
    const int sw = (fr >> 1) & 7;
    const int a_off = (wr * (BM / 2) + fr) * 128, b_off = BM * 128 + (wc * 64 + fr) * 128;
    const int o0 = (fq ^ sw) * 16, o1 = ((4 + fq) ^ sw) * 16;
    const int wbase = wid * 1024;
#define GC_STAGE(step, buf) do { LAS char* _s = lds + (buf) * STAGE + wbase; \
        _Pragma("unroll") for (int _i = 0; _i < NA; ++_i) __builtin_amdgcn_global_load_lds((const GAS unsigned*)af((step), _i), (LAS unsigned*)(_s + _i * 4096), 16, 0, 0); \
        _Pragma("unroll") for (int _i = 0; _i < 4; ++_i) __builtin_amdgcn_global_load_lds((const GAS unsigned*)bf((step), _i), (LAS unsigned*)(_s + BM * 128 + _i * 4096), 16, 0, 0); } while (0)
    GC_STAGE(0, 0);
    asm volatile("s_waitcnt vmcnt(0)" ::: "memory");
    __syncthreads();
    for (int t = 0; t < nsteps; ++t) {
        const int buf = t & 1;
        if (t + 1 < nsteps) GC_STAGE(t + 1, buf ^ 1);
        const LAS char* sa = lds + buf * STAGE + a_off;
        const LAS char* sb = lds + buf * STAGE + b_off;
#pragma unroll
        for (int ks = 0; ks < 2; ++ks) {
            const int off = ks ? o1 : o0;
            bf16x8 fa[MI], fb[4];
#pragma unroll
            for (int m = 0; m < MI; ++m) fa[m] = *(const LAS bf16x8*)(sa + m * 2048 + off);
#pragma unroll
            for (int n = 0; n < 4; ++n) fb[n] = *(const LAS bf16x8*)(sb + n * 2048 + off);
#pragma unroll
            for (int m = 0; m < MI; ++m)
#pragma unroll
                for (int n = 0; n < 4; ++n) acc[m][n] = __builtin_amdgcn_mfma_f32_16x16x32_bf16(fb[n], fa[m], acc[m][n], 0, 0, 0);
        }
        asm volatile("s_waitcnt vmcnt(0)" ::: "memory");
        __syncthreads();
    }
#undef GC_STAGE
}
template <int MI> DEV void zero_acc(f32x4 (&acc)[MI][4]) {
#pragma unroll
    for (int m = 0; m < MI; ++m)
#pragma unroll
        for (int n = 0; n < 4; ++n) acc[m][n] = (f32x4){0.f, 0.f, 0.f, 0.f};
}
#define EPI_VARS(BM) const int _tq = tidx(); const int _lane = _tq & 63, _wid = _tq >> 6, _wr = _wid >> 1, _wc = _wid & 1, _fr = _lane & 15, _fq = _lane >> 4; (void)_wc; (void)_fq; (void)_fr; (void)_wr;
#define EPI_ROW(BM, m) (_wr * ((BM) / 2) + (m) * 16 + _fr)
#define EPI_COL(n) (_wc * 64 + (n) * 16 + _fq * 4)

DEV void st_bf4(bf16_t* dst, f32x4 v) { u32x2 w; w.x = pk2(v[0], v[1]); w.y = pk2(v[2], v[3]); *(u32x2*)dst = w; }
DEV f32x4 ld_bf4(const bf16_t* src) { const u32x2 w = *(const u32x2*)src; return (f32x4){bflo(w.x), bfhi(w.x), bflo(w.y), bfhi(w.y)}; }

template <class CP>
DEV void cvt_tile(const CP& colptr, int ld, const float* kscale, bf16_t* dst, int Kdst, int n0, int k0, LAS float* tile) {
    const int tid = tidx(), tx = tid & 63, ty = tid >> 6;
    const float* cp = colptr(n0 + tx);
#pragma unroll 4
    for (int i = 0; i < 16; ++i) {
        const int k = ty + 4 * i;
        float v = cp ? cp[(size_t)(k0 + k) * ld] : 0.f;
        if (kscale) v *= kscale[k0 + k];
        tile[k * 65 + tx] = v;
    }
    __syncthreads();
#pragma unroll
    for (int j = 0; j < 2; ++j) {
        const int c = tid + 256 * j, row = c >> 3, kc = c & 7;
        const LAS float* s = tile + (kc * 8) * 65 + row;
        u32x4 o; o.x = pk2(s[0], s[65]); o.y = pk2(s[2 * 65], s[3 * 65]); o.z = pk2(s[4 * 65], s[5 * 65]); o.w = pk2(s[6 * 65], s[7 * 65]);
        *(u32x4*)(dst + (size_t)(n0 + row) * Kdst + k0 + kc * 8) = o;
    }
    __syncthreads();
}
DEV void glu_map(int np, int& isgate, int& idx) { const int t = np >> 7, w = (np >> 6) & 1, within = np & 63; isgate = within >> 5; idx = t * 64 + w * 32 + (within & 31); }

DEV void cvt_early_item(int it, LAS char* lds) {
    const KA p = get_ka();
    LAS float* tile = (LAS float*)lds;
    constexpr int PER_LAYER = 2464;
    const int l = it / PER_LAYER; int r = it % PER_LAYER;
    char* wl = p.ws() + OFF_W + (size_t)l * W_LAYER;
    const float* w_in = (const float*)p.in(5) + (size_t)l * D_ * NIN_;
    if (r < 640) { const int nt = r / 16, kt = r % 16;
        cvt_tile([&](int n) -> const float* { return n < NMIX_ ? w_in + n : nullptr; }, NIN_, nullptr, (bf16_t*)(wl + W_IN), 1024, nt * 64, kt * 64, tile); return; } r -= 640;
    if (r < 768) { const int nt = r / 16, kt = r % 16;
        cvt_tile([&](int n) -> const float* { return w_in + NMIX_ + n; }, NIN_, nullptr, (bf16_t*)(wl + W_G), 1024, nt * 64, kt * 64, tile); return; } r -= 768;
    if (r < 128) { const int nt = r / 8, kt = r % 8; const float* w = (const float*)p.in(15) + (size_t)l * 512 * 1024;
        cvt_tile([&](int n) -> const float* { int g, idx; glu_map(n, g, idx); return w + g * 512 + idx; }, 1024, nullptr, (bf16_t*)(wl + W_GLU), 512, nt * 64, kt * 64, tile); return; } r -= 128;
    if (r < 64) { const int nt = r / 4, kt = r % 4; const float* w = (const float*)p.in(17) + (size_t)l * 256 * 768;
        cvt_tile([&](int n) -> const float* { const int h = n >> 7, d = n & 127; if (d >= 96) return nullptr; int c = d; if (d >= 64) { const int i = (d - 64) >> 1, part = (d - 64) & 1; c = 64 + part * 16 + i; } return w + h * 96 + c; },
                 768, (const float*)p.in(16) + l * 256, (bf16_t*)(wl + W_UQ), 256, nt * 64, kt * 64, tile); return; } r -= 64;
    if (r < 16) { const int nt = r / 2, kt = r % 2; const float* w = (const float*)p.in(19) + (size_t)l * 128 * 512;
        cvt_tile([&](int n) -> const float* { return w + n; }, 512, (const float*)p.in(18) + l * 128, (bf16_t*)(wl + W_UK), 128, nt * 64, kt * 64, tile); return; } r -= 16;
    if (r < 16) { const int nt = r / 2, kt = r % 2; const float* w = (const float*)p.in(20) + (size_t)l * 128 * 512;
        cvt_tile([&](int n) -> const float* { return w + n; }, 512, (const float*)p.in(18) + l * 128, (bf16_t*)(wl + W_UV), 128, nt * 64, kt * 64, tile); return; } r -= 16;
    if (r < 384) { const int which = r / 128, rr = r % 128, nt = rr / 8, kt = rr % 8; const float* w = (const float*)p.in(21 + which) + (size_t)l * 512 * 1024;
        cvt_tile([&](int n) -> const float* { return w + n; }, 1024, nullptr, (bf16_t*)(wl + W_UPC + (size_t)which * 1024 * 512 * 2), 512, nt * 64, kt * 64, tile); return; } r -= 384;
    if (r < 256) { const int nt = r / 16, kt = r % 16; const float* w = (const float*)p.in(24) + (size_t)l * 1024 * 1024;
        cvt_tile([&](int n) -> const float* { return w + n; }, 1024, nullptr, (bf16_t*)(wl + W_O), 1024, nt * 64, kt * 64, tile); return; } r -= 256;
    if (r < 128) { const int nt = r / 16, kt = r % 16; const float* w1 = (const float*)p.in(32) + (size_t)l * 1024 * 256; const float* w3 = (const float*)p.in(33) + (size_t)l * 1024 * 256;
        cvt_tile([&](int n) -> const float* { int g, idx; glu_map(n, g, idx); return (g ? w3 : w1) + idx; }, 256, nullptr, (bf16_t*)(wl + W_S13), 1024, nt * 64, kt * 64, tile); return; } r -= 128;
    { const int nt = r / 4, kt = r % 4; const float* w = (const float*)p.in(34) + (size_t)l * 256 * 1024;
        cvt_tile([&](int n) -> const float* { return w + n; }, 1024, nullptr, (bf16_t*)(wl + W_S2), 256, nt * 64, kt * 64, tile); }
}
constexpr int NCVT_EARLY = 2 * 2464;
DEV void cvt_expert_item(int l, int it, LAS char* lds) {
    const KA p = get_ka();
    LAS float* tile = (LAS float*)lds;
    const int e = it / 192; int r = it % 192;
    if (r < 128) { const int nt = r / 16, kt = r % 16;
        const float* w1 = (const float*)p.in(29) + ((size_t)l * 32 + e) * 1024 * 256; const float* w3 = (const float*)p.in(30) + ((size_t)l * 32 + e) * 1024 * 256;
        cvt_tile([&](int n) -> const float* { int g, idx; glu_map(n, g, idx); return (g ? w3 : w1) + idx; }, 256, nullptr, (bf16_t*)(p.ws() + OFF_E13) + (size_t)e * 512 * 1024, 1024, nt * 64, kt * 64, tile); return; }
    r -= 128;
    { const int nt = r / 4, kt = r % 4; const float* w = (const float*)p.in(31) + ((size_t)l * 32 + e) * 256 * 1024;
        cvt_tile([&](int n) -> const float* { return w + n; }, 1024, nullptr, (bf16_t*)(p.ws() + OFF_E2) + (size_t)e * 1024 * 256, 256, nt * 64, kt * 64, tile); }
}

DEV void ada_item(int it, LAS char* lds) {
    const KA p = get_ka();
    LAS float* sc = (LAS float*)lds;
    LAS float* red = sc + 8192;
    const int tid = tidx(), l = it / 96, j0 = (it % 96) * 64, kq = tid >> 6, cj = tid & 63;
    const float* c = (const float*)p.in(1);
    for (int i = tid; i < 8192; i += 256) sc[i] = siluf_(c[i]);
    __syncthreads();
    const float* w = (const float*)p.in(3) + (size_t)l * 1024 * 6144 + j0 + cj;
    float a[8];
#pragma unroll
    for (int b = 0; b < 8; ++b) a[b] = 0.f;
#pragma unroll 4
    for (int k = kq * 256; k < kq * 256 + 256; ++k) {
        const float wv = w[(size_t)k * 6144];
#pragma unroll
        for (int b = 0; b < 8; ++b) a[b] += sc[b * 1024 + k] * wv;
    }
#pragma unroll
    for (int b = 0; b < 8; ++b) red[(kq * 64 + cj) * 8 + b] = a[b];
    __syncthreads();
    for (int i = tid; i < 512; i += 256) {
        const int b = i >> 6, jj = i & 63;
        const float s = red[(0 * 64 + jj) * 8 + b] + red[(1 * 64 + jj) * 8 + b] + red[(2 * 64 + jj) * 8 + b] + red[(3 * 64 + jj) * 8 + b];
        ((float*)(p.ws() + OFF_ADA))[((size_t)l * 8 + b) * 6144 + j0 + jj] = s + ((const float*)p.in(4))[l * 6144 + j0 + jj];
    }
    __syncthreads();
}

DEV void ln_finish_row(f32x4 (&v)[4], const int lane, const float* lng, const float* lnb, float* xout_row, const float* sh, const float* sc, bf16_t* h_row) {
    float s = 0.f;
#pragma unroll
    for (int j = 0; j < 4; ++j) s += (v[j][0] + v[j][1]) + (v[j][2] + v[j][3]);
    float mean = wave_sum(s) * (1.f / 1024.f), q = 0.f;
#pragma unroll
    for (int j = 0; j < 4; ++j) { v[j] = v[j] - mean; q += (v[j][0] * v[j][0] + v[j][1] * v[j][1]) + (v[j][2] * v[j][2] + v[j][3] * v[j][3]); }
    float rstd = rsqrtf(wave_sum(q) * (1.f / 1024.f) + 1e-5f);
    if (lng) {
#pragma unroll
        for (int j = 0; j < 4; ++j) {
            const int col = 4 * lane + 256 * j;
            const f32x4 g = *(const f32x4*)(lng + col), b = *(const f32x4*)(lnb + col);
            v[j] = v[j] * rstd * g + b;
            *(f32x4*)(xout_row + col) = v[j];
        }
        if (!h_row) return;
        s = 0.f;
#pragma unroll
        for (int j = 0; j < 4; ++j) s += (v[j][0] + v[j][1]) + (v[j][2] + v[j][3]);
        mean = wave_sum(s) * (1.f / 1024.f); q = 0.f;
#pragma unroll
        for (int j = 0; j < 4; ++j) { v[j] = v[j] - mean; q += (v[j][0] * v[j][0] + v[j][1] * v[j][1]) + (v[j][2] * v[j][2] + v[j][3] * v[j][3]); }
        rstd = rsqrtf(wave_sum(q) * (1.f / 1024.f) + 1e-5f);
    }
#pragma unroll
    for (int j = 0; j < 4; ++j) {
        const int col = 4 * lane + 256 * j;
        const f32x4 a = *(const f32x4*)(sc + col), b = *(const f32x4*)(sh + col);
        const f32x4 o = v[j] * rstd * (a + 1.f) + b;
        st_bf4(h_row + col, o);
    }
}

DEV void phase0(LAS char* lds) {
    const KA p = get_ka();
    const int tid = threadIdx.x, nb = gridDim.x, bid = blockIdx.x;
    unsigned* ctrl = (unsigned*)(p.ws() + OFF_CTRL);
    if (bid == 0) for (int i = tid; i < CTRL_WORDS; i += 256) ctrl[i] = 0u;
    for (int it = bid; it < 192; it += nb) ada_item(it, lds);
    {
        const int* pos = (const int*)p.in(2); float2* cs = (float2*)(p.ws() + OFF_CS);
        for (int idx = bid * 256 + tid; idx < T_ * 16; idx += nb * 256) {
            const int t = idx >> 4, i = idx & 15;
            const float invf = powf(10000.f, -(float)(2 * i) / 32.f);
            const float ang = (float)pos[t] * invf;
            float sn, cn; sincosf(ang, &sn, &cn);
            cs[idx] = make_float2(cn, sn);
        }
    }
    {
        const float* rw = (const float*)p.in(27); bf16_t* wr = (bf16_t*)(p.ws() + OFF_WR);
        for (int idx = bid * 256 + tid; idx < 128 * 2048; idx += nb * 256) {
            const int e = idx >> 11, k = idx & 2047; bf16_t o = 0;
            if (e < 32) { const float w = rw[(k & 1023) * 32 + e]; const bf16_t hi = f2bf(w); o = (k < 1024) ? hi : f2bf(w - bf2f(hi)); }
            wr[idx] = o;
        }
    }
    for (int it = (bid + nb - (192 % nb)) % nb; it < NCVT_EARLY; it += nb) cvt_early_item(it, lds);
}

DEV void phase_lnmod0() {
    const KA p = get_ka();
    const int lane = threadIdx.x & 63, gw = blockIdx.x * 4 + (threadIdx.x >> 6), ngw = gridDim.x * 4;
    const float* x = (const float*)p.in(0); const float* ada = (const float*)(p.ws() + OFF_ADA);
    bf16_t* H = (bf16_t*)(p.ws() + OFF_H);
    for (int row = gw; row < T_; row += ngw) {
        const int b = row >> 12;
        f32x4 v[4];
#pragma unroll
        for (int j = 0; j < 4; ++j) v[j] = *(const f32x4*)(x + (size_t)row * 1024 + 4 * lane + 256 * j);
        ln_finish_row(v, lane, nullptr, nullptr, nullptr, ada + b * 6144 + 0, ada + b * 6144 + 1024, H + (size_t)row * 1024);
    }
}

DEV void pa_tile(int l, int mt, int nt, LAS char* lds) {
    const KA p = get_ka();
    const char* wl = p.ws() + OFF_W + (size_t)l * W_LAYER;
    f32x4 acc[4][4]; zero_acc<4>(acc);
    const RowsF<4> af = mk_rows<4>(p.ws() + OFF_H, 2048, mt * 128);
    const RowsF<4> bf = mk_rows<4>(wl + W_IN, 2048, nt * 128);
    gemm_core<128>(acc, 16, af, bf, lds);
    EPI_VARS(128)
    bf16_t* dst; int pitch, ncol = 128;
    if (nt < 12) { dst = (bf16_t*)(p.ws() + OFF_XC + (size_t)(nt >> 2) * 32 * MiB) + (nt & 3) * 128; pitch = 512; }
    else if (nt < 16) { dst = (bf16_t*)(p.ws() + OFF_USSM) + (nt - 12) * 128; pitch = 512; }
    else if (nt < 18) { dst = (bf16_t*)(p.ws() + OFF_CQ) + (nt - 16) * 128; pitch = 256; }
    else if (nt < 19) { dst = (bf16_t*)(p.ws() + OFF_CKV); pitch = 128; }
    else { dst = (bf16_t*)(p.ws() + OFF_KR); pitch = 32; ncol = 32; }
#pragma unroll
    for (int m = 0; m < 4; ++m) {
        const int row = mt * 128 + EPI_ROW(128, m);
#pragma unroll
        for (int n = 0; n < 4; ++n) {
            const int col = EPI_COL(n);
            if (col < ncol) st_bf4(dst + (size_t)row * pitch + col, acc[m][n]);
        }
    }
}

DEV void ssm_pre_item(int l, int g, LAS char* lds) {
    const KA p = get_ka();
    LAS float* pwr = (LAS float*)lds;
    LAS float* pwi = pwr + 33 * 64;
    LAS float* ffr = pwi + 33 * 64;
    LAS float* ffi = ffr + 64;
    LAS float* ktab = ffi + 64;
    const int tid = tidx(), lg = l * 32 + g;
    const float dt = expf(((const float*)p.in(14))[lg]);
    const float* a_re = (const float*)p.in(7) + lg * 64; const float* a_im = (const float*)p.in(8) + lg * 64;
    const float* b_re = (const float*)p.in(9) + (size_t)lg * 64 * 16; const float* b_im = (const float*)p.in(10) + (size_t)lg * 64 * 16;
    const float* c_re = (const float*)p.in(11) + (size_t)lg * 16 * 64; const float* c_im = (const float*)p.in(12) + (size_t)lg * 16 * 64;
    for (int i = tid; i < 33 * 64; i += 256) {
        const int e = i >> 6, n = i & 63;
        const float mag = expf(a_re[n] * dt * (float)e); float sn, cn; sincosf(a_im[n] * dt * (float)e, &sn, &cn);
        pwr[i] = mag * cn; pwi[i] = mag * sn;
    }
    if (tid < 64) {
        const int n = tid; const float ar = a_re[n], ai = a_im[n];
        const float mag = expf(ar * dt); float sn, cn; sincosf(ai * dt, &sn, &cn);
        const float lre = mag * cn, lim = mag * sn, den = ar * ar + ai * ai, nr = lre - 1.f, ni = lim;
        ffr[n] = (nr * ar + ni * ai) / den; ffi[n] = (ni * ar - nr * ai) / den;
    }
    __syncthreads();
    {
        const int pp = tid >> 4, q = tid & 15;
        float acc[32];
#pragma unroll
        for (int k = 0; k < 32; ++k) acc[k] = 0.f;
        for (int n = 0; n < 64; ++n) {
            const float cre = c_re[pp * 64 + n], cim = c_im[pp * 64 + n];
            const float br = b_re[n * 16 + q], bi = b_im[n * 16 + q];
            const float fr = ffr[n], fi = ffi[n];
            const float bbr = fr * br - fi * bi, bbi = fr * bi + fi * br;
            const float wre = cre * bbr - cim * bbi, wim = cre * bbi + cim * bbr;
#pragma unroll
            for (int k = 0; k < 32; ++k) acc[k] += wre * pwr[k * 64 + n] - wim * pwi[k * 64 + n];
        }
#pragma unroll
        for (int k = 0; k < 32; ++k) ktab[k * 256 + pp * 16 + q] = acc[k];
    }
    __syncthreads();
    bf16_t* BT = (bf16_t*)(p.ws() + OFF_SBT) + (size_t)g * 512 * 768;
    for (int c = tid; c < 512 * 64; c += 256) {
        const int row = c >> 6, kc = c & 63, i = row >> 4, pp = row & 15, j = kc >> 1, q0 = (kc & 1) * 8;
        u32x4 o = (u32x4){0u, 0u, 0u, 0u};
        if (i >= j) { const LAS float* s = ktab + (i - j) * 256 + pp * 16 + q0; o.x = pk2(s[0], s[1]); o.y = pk2(s[2], s[3]); o.z = pk2(s[4], s[5]); o.w = pk2(s[6], s[7]); }
        *(u32x4*)(BT + (size_t)row * 768 + kc * 8) = o;
    }
    for (int c = tid; c < 512 * 16; c += 256) {
        const int row = c >> 4, kc2 = c & 15, i = row >> 4, pp = row & 15, n0 = (kc2 & 7) * 8, part = kc2 >> 3;
        float v[8];
#pragma unroll
        for (int e = 0; e < 8; ++e) {
            const int n = n0 + e; const float cre = c_re[pp * 64 + n], cim = c_im[pp * 64 + n], lr = pwr[(i + 1) * 64 + n], li = pwi[(i + 1) * 64 + n];
            v[e] = part == 0 ? (cre * lr - cim * li) : -(cre * li + cim * lr);
        }
        u32x4 o; o.x = pk2(v[0], v[1]); o.y = pk2(v[2], v[3]); o.z = pk2(v[4], v[5]); o.w = pk2(v[6], v[7]);
        *(u32x4*)(BT + (size_t)row * 768 + 512 + kc2 * 8) = o;
        *(u32x4*)(BT + (size_t)row * 768 + 640 + kc2 * 8) = o;
    }
    bf16_t* SG = (bf16_t*)(p.ws() + OFF_SG) + (size_t)g * 128 * 512;
    for (int c = tid; c < 128 * 64; c += 256) {
        const int row = c >> 6, kc = c & 63, n = row & 63, part = row >> 6, j = kc >> 1, q0 = (kc & 1) * 8;
        const float lr = pwr[(31 - j) * 64 + n], li = pwi[(31 - j) * 64 + n], fr = ffr[n], fi = ffi[n];
        float v[8];
#pragma unroll
        for (int e = 0; e < 8; ++e) {
            const float br = b_re[n * 16 + q0 + e], bi = b_im[n * 16 + q0 + e];
            const float bbr = fr * br - fi * bi, bbi = fr * bi + fi * br;
            v[e] = part == 0 ? (lr * bbr - li * bbi) : (lr * bbi + li * bbr);
        }
        u32x4 o; o.x = pk2(v[0], v[1]); o.y = pk2(v[2], v[3]); o.z = pk2(v[4], v[5]); o.w = pk2(v[6], v[7]);
        *(u32x4*)(SG + (size_t)row * 512 + kc * 8) = o;
    }
    if (tid < 64) ((float2*)(p.ws() + OFF_LAML))[g * 64 + tid] = make_float2(pwr[32 * 64 + tid], pwi[32 * 64 + tid]);
    __syncthreads();
}

DEV void phase_a(int l, LAS char* lds) {
    const int nb = gridDim.x, bid = blockIdx.x;
    for (int it = bid; it < 32; it += nb) ssm_pre_item(l, it, lds);
    for (int it = bid; it < 32 * 192; it += nb) cvt_expert_item(l, it, lds);
    for (int it = bid; it < 256 * 20; it += nb) pa_tile(l, it / 20, it % 20, lds);
}

DEV void rows_rinv(const bf16_t* base, int ncols, int row0, LAS char* lds) {
    LAS float* tbl = (LAS float*)(lds + LDS_WORK + 256);
    const int tid = tidx(), row = tid >> 1, half = tid & 1, n = ncols >> 1;
    const bf16_t* src = base + (size_t)(row0 + row) * ncols + half * n;
    float s = 0.f;
    for (int c = 0; c < n; c += 8) {
        const u32x4 w = *(const u32x4*)(src + c);
        const float a0 = bflo(w.x), a1 = bfhi(w.x), a2 = bflo(w.y), a3 = bfhi(w.y), a4 = bflo(w.z), a5 = bfhi(w.z), a6 = bflo(w.w), a7 = bfhi(w.w);
        s += (a0 * a0 + a1 * a1) + (a2 * a2 + a3 * a3) + (a4 * a4 + a5 * a5) + (a6 * a6 + a7 * a7);
    }
    s += __shfl_xor(s, 1);
    __syncthreads();
    if (!half) tbl[row] = rsqrtf(s / (float)ncols + 1e-6f);
    __syncthreads();
}
DEV void pb_q_tile(int l, int mt, int h, LAS char* lds) {
    const KA p = get_ka();
    const char* wl = p.ws() + OFF_W + (size_t)l * W_LAYER;
    rows_rinv((const bf16_t*)(p.ws() + OFF_CQ), 256, mt * 128, lds);
    f32x4 acc[4][4]; zero_acc<4>(acc);
    const RowsF<4> af = mk_rows<4>(p.ws() + OFF_CQ, 512, mt * 128);
    const RowsF<4> bf = mk_rows<4>(wl + W_UQ, 512, h * 128);
    gemm_core<128>(acc, 4, af, bf, lds);
    EPI_VARS(128)
    const LAS float* tbl = (const LAS float*)(lds + LDS_WORK + 256);
    const float2* cs = (const float2*)(p.ws() + OFF_CS); bf16_t* Q = (bf16_t*)(p.ws() + OFF_Q);
#pragma unroll
    for (int m = 0; m < 4; ++m) {
        const int rloc = EPI_ROW(128, m), row = mt * 128 + rloc, b = row >> 12, s = row & 4095;
        const float rinv = tbl[rloc] * QSCALE_;
#pragma unroll
        for (int n = 0; n < 4; ++n) {
            const int d = EPI_COL(n);
            if (d < 96) {
                f32x4 v = acc[m][n] * rinv;
                if (d >= 64) {
                    const int i = (d - 64) >> 1; const float2 c0 = cs[row * 16 + i], c1 = cs[row * 16 + i + 1];
                    v = (f32x4){v[0] * c0.x - v[1] * c0.y, v[0] * c0.y + v[1] * c0.x, v[2] * c1.x - v[3] * c1.y, v[2] * c1.y + v[3] * c1.x};
                }
                st_bf4(Q + ((size_t)(b * 8 + h) * 4096 + s) * 96 + d, v);
            }
        }
    }
}
DEV void pb_k_tile(int l, int mt, int nt, LAS char* lds) {
    const KA p = get_ka();
    const char* wl = p.ws() + OFF_W + (size_t)l * W_LAYER;
    rows_rinv((const bf16_t*)(p.ws() + OFF_CKV), 128, mt * 128, lds);
    f32x4 acc[4][4]; zero_acc<4>(acc);
    const RowsF<4> af = mk_rows<4>(p.ws() + OFF_CKV, 256, mt * 128);
    const RowsF<4> bf = mk_rows<4>(wl + W_UK, 256, nt * 128);
    gemm_core<128>(acc, 2, af, bf, lds);
    EPI_VARS(128)
    const LAS float* tbl = (const LAS float*)(lds + LDS_WORK + 256);
    bf16_t* KN = (bf16_t*)(p.ws() + OFF_KN);
#pragma unroll
    for (int m = 0; m < 4; ++m) {
        const int rloc = EPI_ROW(128, m), row = mt * 128 + rloc, b = row >> 12, s = row & 4095;
        const float rinv = tbl[rloc];
#pragma unroll
        for (int n = 0; n < 4; ++n) {
            const int col = nt * 128 + EPI_COL(n), h = col >> 6, d = col & 63;
            st_bf4(KN + ((size_t)(b * 8 + h) * 4096 + s) * 64 + d, acc[m][n] * rinv);
        }
    }
}
DEV void pb_v_tile(int l, int mt, int nt, LAS char* lds) {
    const KA p = get_ka();
    const char* wl = p.ws() + OFF_W + (size_t)l * W_LAYER;
    rows_rinv((const bf16_t*)(p.ws() + OFF_CKV), 128, nt * 128, lds);
    f32x4 acc[4][4]; zero_acc<4>(acc);
    const RowsF<4> af = mk_rows<4>(wl + W_UV, 256, mt * 128);
    const RowsF<4> bf = mk_rows<4>(p.ws() + OFF_CKV, 256, nt * 128);
    gemm_core<128>(acc, 2, af, bf, lds);
    EPI_VARS(128)
    const LAS float* tbl = (const LAS float*)(lds + LDS_WORK + 256);
    bf16_t* VT = (bf16_t*)(p.ws() + OFF_VT);
#pragma unroll
    for (int n = 0; n < 4; ++n) {
        const int cloc = EPI_COL(n), tok = nt * 128 + cloc, b = tok >> 12, s = tok & 4095;
        const f32x4 rinv = (f32x4){tbl[cloc], tbl[cloc + 1], tbl[cloc + 2], tbl[cloc + 3]};
#pragma unroll
        for (int m = 0; m < 4; ++m) {
            const int r = mt * 128 + EPI_ROW(128, m), h = r >> 6, dv = r & 63;
            st_bf4(VT + ((size_t)(b * 8 + h) * 64 + dv) * 4096 + s, acc[m][n] * rinv);
        }
    }
}
DEV void pb_elem_item(int l, int it) {
    const KA p = get_ka();
    const int tid = tidx(), t0 = it * 64;
    const bf16_t* xc = (const bf16_t*)(p.ws() + OFF_XC); const bf16_t* gc = (const bf16_t*)(p.ws() + OFF_GC); bf16_t* gbp = (bf16_t*)(p.ws() + OFF_GB);
    const float* cw = (const float*)p.in(6) + l * 3 * 512;
    {
        const int ch = (tid & 63) * 8;
        float w0[8], w1[8], w2[8];
#pragma unroll
        for (int e = 0; e < 8; ++e) { w0[e] = cw[ch + e]; w1[e] = cw[512 + ch + e]; w2[e] = cw[1024 + ch + e]; }
        for (int tt = tid >> 6; tt < 64; tt += 4) {
            const int t = t0 + tt, s = t & 4095;
            const size_t o = (size_t)t * 512 + ch;
            float u0[8], u1[8], u2[8], gbv[8];
            {
                const u32x4 a = *(const u32x4*)(xc + o), g = *(const u32x4*)(gc + o), gb = *(const u32x4*)(gbp + o);
                const unsigned aw[4] = {a.x, a.y, a.z, a.w}, gw[4] = {g.x, g.y, g.z, g.w}, bw[4] = {gb.x, gb.y, gb.z, gb.w};
#pragma unroll
                for (int e = 0; e < 4; ++e) { u2[2 * e] = bflo(aw[e]) * bflo(gw[e]); u2[2 * e + 1] = bfhi(aw[e]) * bfhi(gw[e]); gbv[2 * e] = bflo(bw[e]); gbv[2 * e + 1] = bfhi(bw[e]); }
            }
            if (s >= 1) {
                const u32x4 a = *(const u32x4*)(xc + o - 512), g = *(const u32x4*)(gc + o - 512);
                const unsigned aw[4] = {a.x, a.y, a.z, a.w}, gw[4] = {g.x, g.y, g.z, g.w};
#pragma unroll
                for (int e = 0; e < 4; ++e) { u1[2 * e] = bflo(aw[e]) * bflo(gw[e]); u1[2 * e + 1] = bfhi(aw[e]) * bfhi(gw[e]); }
            } else {
#pragma unroll
                for (int e = 0; e < 8; ++e) u1[e] = 0.f;
            }
            if (s >= 2) {
                const u32x4 a = *(const u32x4*)(xc + o - 1024), g = *(const u32x4*)(gc + o - 1024);
                const unsigned aw[4] = {a.x, a.y, a.z, a.w}, gw[4] = {g.x, g.y, g.z, g.w};
#pragma unroll
                for (int e = 0; e < 4; ++e) { u0[2 * e] = bflo(aw[e]) * bflo(gw[e]); u0[2 * e + 1] = bfhi(aw[e]) * bfhi(gw[e]); }
            } else {
#pragma unroll
                for (int e = 0; e < 8; ++e) u0[e] = 0.f;
            }
            float ov[8];
#pragma unroll
            for (int e = 0; e < 8; ++e) ov[e] = gbv[e] * (w0[e] * u0[e] + w1[e] * u1[e] + w2[e] * u2[e]);
            u32x4 o4; o4.x = pk2(ov[0], ov[1]); o4.y = pk2(ov[2], ov[3]); o4.z = pk2(ov[4], ov[5]); o4.w = pk2(ov[6], ov[7]);
            *(u32x4*)(gbp + o) = o4;
        }
    }
    {
        const bf16_t* kr = (const bf16_t*)(p.ws() + OFF_KR); const float2* cs = (const float2*)(p.ws() + OFF_CS); bf16_t* KRP = (bf16_t*)(p.ws() + OFF_KRP);
        for (int idx = tid; idx < 64 * 16; idx += 256) {
            const int t = t0 + (idx >> 4), i = idx & 15;
            const float x1 = bf2f(kr[t * 32 + i]), x2 = bf2f(kr[t * 32 + 16 + i]); const float2 c = cs[t * 16 + i];
            *(unsigned*)(KRP + (size_t)t * 32 + 2 * i) = pk2(x1 * c.x - x2 * c.y, x1 * c.y + x2 * c.x);
        }
    }
}
DEV void phase_b(int l, LAS char* lds) {
    const int nb = gridDim.x, bid = blockIdx.x;
    for (int it = bid; it < 512; it += nb) pb_elem_item(l, it);
    for (int it = bid; it < 2048; it += nb) pb_q_tile(l, it >> 3, it & 7, lds);
    for (int it = bid; it < 1024; it += nb) pb_k_tile(l, it >> 2, it & 3, lds);
    for (int it = bid; it < 1024; it += nb) pb_v_tile(l, it & 3, it >> 2, lds);
}

DEV void attn_item(int b, int h, int qb, LAS char* lds) {
    const KA p = get_ka();
    constexpr int KN = 0, KR = 8192, VV = 12288, ST = 20480;
    const int tid = tidx(), lane = tid & 63, wid = tid >> 6, r = lane & 31, hh = lane >> 5;
    const int bh = b * 8 + h, q0 = qb * 128 + wid * 32;
    const bf16_t* Qp = (const bf16_t*)(p.ws() + OFF_Q) + ((size_t)bh * 4096 + q0 + r) * 96;
    bf16x8 qf[6];
#pragma unroll
    for (int s = 0; s < 6; ++s) qf[s] = *(const bf16x8*)(Qp + 16 * s + 8 * hh);
    const char* Kg = p.ws() + OFF_KN + (size_t)bh * 4096 * 128;
    const char* Rg = p.ws() + OFF_KRP + (size_t)b * 4096 * 64;
    const char* Vg = p.ws() + OFF_VT + (size_t)bh * 64 * 8192;
    const char* kn_src[2]; const char* v_src[2]; const char* kr_src;
#pragma unroll
    for (int i = 0; i < 2; ++i) {
        const int pp = tid + 256 * i, row = pp >> 3, s = pp & 7, q = s ^ ((row >> 1) & 7);
        const int key = (row & ~12) | ((row & 4) << 1) | ((row & 8) >> 1);
        kn_src[i] = Kg + (size_t)key * 128 + q * 16;
        v_src[i] = Vg + (size_t)row * 8192 + q * 16;
    }
    {
        const int row = tid >> 2, s = tid & 3, g = (row >> 2) & 3, f = (0x78 >> (2 * g)) & 3, q = s ^ f;
        const int key = (row & ~12) | ((row & 4) << 1) | ((row & 8) >> 1);
        kr_src = Rg + (size_t)key * 64 + q * 16;
    }
    const int wbase = wid * 1024;
#define AT_STAGE(t, buf) do { LAS char* _s = lds + (buf) * ST + wbase; \
        __builtin_amdgcn_global_load_lds((const GAS unsigned*)(kn_src[0] + (size_t)(t) * (64 * 128)), (LAS unsigned*)(_s + KN), 16, 0, 0); \
        __builtin_amdgcn_global_load_lds((const GAS unsigned*)(kn_src[1] + (size_t)(t) * (64 * 128)), (LAS unsigned*)(_s + KN + 4096), 16, 0, 0); \
        __builtin_amdgcn_global_load_lds((const GAS unsigned*)(kr_src + (size_t)(t) * (64 * 64)), (LAS unsigned*)(_s + KR), 16, 0, 0); \
        __builtin_amdgcn_global_load_lds((const GAS unsigned*)(v_src[0] + (size_t)(t) * 128), (LAS unsigned*)(_s + VV), 16, 0, 0); \
        __builtin_amdgcn_global_load_lds((const GAS unsigned*)(v_src[1] + (size_t)(t) * 128), (LAS unsigned*)(_s + VV + 4096), 16, 0, 0); } while (0)
    f32x16 o0, o1;
#pragma unroll
    for (int i = 0; i < 16; ++i) { o0[i] = 0.f; o1[i] = 0.f; }
    float mrun = -INFINITY, lrun = 0.f;
    const int ntiles = 2 * qb + 2;
    const int swn = (r >> 1) & 7;
    const int fro = (0x78 >> (2 * ((r >> 2) & 3))) & 3;
    AT_STAGE(0, 0);
    asm volatile("s_waitcnt vmcnt(0)" ::: "memory");
    __syncthreads();
    for (int t = 0; t < ntiles; ++t) {
        const int buf = t & 1;
        if (t + 1 < ntiles) AT_STAGE(t + 1, buf ^ 1);
        const int key0 = t * 64;
        if (key0 <= q0 + 31) {
            const LAS char* base = lds + buf * ST;
            f32x16 st[2];
#pragma unroll
            for (int kb = 0; kb < 2; ++kb) {
                f32x16 a;
#pragma unroll
                for (int i = 0; i < 16; ++i) a[i] = 0.f;
                const LAS char* kn = base + KN + (kb * 32 + r) * 128;
                const LAS char* kr = base + KR + (kb * 32 + r) * 64;
#pragma unroll
                for (int s = 0; s < 4; ++s) {
                    const bf16x8 kf = *(const LAS bf16x8*)(kn + (((2 * s + hh) ^ swn) * 16));
                    a = __builtin_amdgcn_mfma_f32_32x32x16_bf16(kf, qf[s], a, 0, 0, 0);
                }
#pragma unroll
                for (int s = 0; s < 2; ++s) {
                    const bf16x8 kf = *(const LAS bf16x8*)(kr + (((2 * s + hh) ^ fro) * 16));
                    a = __builtin_amdgcn_mfma_f32_32x32x16_bf16(kf, qf[4 + s], a, 0, 0, 0);
                }
                st[kb] = a;
            }
            if (key0 + 63 > q0) {
                const int qi = q0 + r;
#pragma unroll
                for (int kb = 0; kb < 2; ++kb)
#pragma unroll
                    for (int i = 0; i < 16; ++i) {
                        const int key = key0 + kb * 32 + (i & 3) + 4 * ((i >> 2) & 1) + 8 * hh + 16 * (i >> 3);
                        if (key > qi) st[kb][i] = -INFINITY;
                    }
            }
            float tm = st[0][0];
#pragma unroll
            for (int i = 1; i < 16; ++i) tm = fmaxf(tm, st[0][i]);
#pragma unroll
            for (int i = 0; i < 16; ++i) tm = fmaxf(tm, st[1][i]);
            tm = fmaxf(tm, __shfl_xor(tm, 32));
            const float mnew = fmaxf(mrun, tm);
            const float alpha = __builtin_amdgcn_exp2f(mrun - mnew);
            mrun = mnew;
            float ps = 0.f;
#pragma unroll
            for (int kb = 0; kb < 2; ++kb)
#pragma unroll
                for (int i = 0; i < 16; ++i) { const float e = __builtin_amdgcn_exp2f(st[kb][i] - mnew); st[kb][i] = e; ps += e; }
            lrun = lrun * alpha + ps;
#pragma unroll
            for (int i = 0; i < 16; ++i) { o0[i] *= alpha; o1[i] *= alpha; }
            const LAS char* v0 = base + VV + r * 128;
            const LAS char* v1 = base + VV + (32 + r) * 128;
#pragma unroll
            for (int kb = 0; kb < 2; ++kb)
#pragma unroll
                for (int s2 = 0; s2 < 2; ++s2) {
                    union { u32x4 u; bf16x8 v; } pb;
                    pb.u.x = pk2(st[kb][8 * s2 + 0], st[kb][8 * s2 + 1]); pb.u.y = pk2(st[kb][8 * s2 + 2], st[kb][8 * s2 + 3]);
                    pb.u.z = pk2(st[kb][8 * s2 + 4], st[kb][8 * s2 + 5]); pb.u.w = pk2(st[kb][8 * s2 + 6], st[kb][8 * s2 + 7]);
                    const int c = (4 * kb + 2 * s2 + hh) ^ swn;
                    const bf16x8 vf0 = *(const LAS bf16x8*)(v0 + c * 16);
                    const bf16x8 vf1 = *(const LAS bf16x8*)(v1 + c * 16);
                    o0 = __builtin_amdgcn_mfma_f32_32x32x16_bf16(vf0, pb.v, o0, 0, 0, 0);
                    o1 = __builtin_amdgcn_mfma_f32_32x32x16_bf16(vf1, pb.v, o1, 0, 0, 0);
                }
        }
        asm volatile("s_waitcnt vmcnt(0)" ::: "memory");
        __syncthreads();
    }
#undef AT_STAGE
    const float ltot = lrun + __shfl_xor(lrun, 32);
    const float inv = 1.f / ltot;
    bf16_t* O = (bf16_t*)(p.ws() + OFF_XC) + (size_t)(b * 4096 + q0 + r) * 512 + h * 64;
#pragma unroll
    for (int g4 = 0; g4 < 4; ++g4) {
        const int dv = 8 * g4 + 4 * hh;
        st_bf4(O + dv, (f32x4){o0[4 * g4] * inv, o0[4 * g4 + 1] * inv, o0[4 * g4 + 2] * inv, o0[4 * g4 + 3] * inv});
        st_bf4(O + 32 + dv, (f32x4){o1[4 * g4] * inv, o1[4 * g4 + 1] * inv, o1[4 * g4 + 2] * inv, o1[4 * g4 + 3] * inv});
    }
}

struct SsmAF { const char* ub; const char* sb; unsigned pu[4]; unsigned ps[4]; int n1;
    DEV const char* operator()(int step, int i) const { return step < n1 ? ub + (pu[i] + (unsigned)step * 4096u) : sb + (ps[i] + (unsigned)(step - n1) * 128u); } };
struct SsmBF { const char* bb; unsigned pb[4]; int n1;
    DEV const char* operator()(int step, int i) const { return bb + (pb[i] + (step < n1 ? (unsigned)step * 128u : 1024u + (unsigned)(step - n1) * 128u)); } };
DEV void ssm_item(int l, int g, int b, LAS char* lds) {
    const KA p = get_ka();
    const int tid = tidx();
    const int sr = stage_row(tid), sq = stage_q(tid);
    const char* U = p.ws() + OFF_USSM;
    float* E = (float*)(p.ws() + OFF_E) + (size_t)(g * 1024 + b * 128) * 128;
    bf16_t* SP = (bf16_t*)(p.ws() + OFF_SPREV) + (size_t)(g * 1024 + b * 128) * 256;
    SsmAF af; af.n1 = 8; af.ub = U + ((size_t)b * 4096 * 512 + g * 16) * 2; af.sb = (const char*)SP;
#pragma unroll
    for (int i = 0; i < 4; ++i) {
        const int row = sr + 32 * i;
        af.pu[i] = (unsigned)((row * 32 + (sq >> 1)) * 512 + (sq & 1) * 8) * 2u;
        af.ps[i] = (unsigned)(row * 256 + sq * 8) * 2u;
    }
    {
        f32x4 acc[4][4]; zero_acc<4>(acc);
        const RowsF<4> bf = mk_rows<4>(p.ws() + OFF_SG + (size_t)g * 128 * 512 * 2, 1024, 0);
        gemm_core<128>(acc, 8, af, bf, lds);
        EPI_VARS(128)
#pragma unroll
        for (int m = 0; m < 4; ++m)
#pragma unroll
            for (int n = 0; n < 4; ++n) *(f32x4*)(E + (size_t)EPI_ROW(128, m) * 128 + EPI_COL(n)) = acc[m][n];
    }
    __syncthreads();
    if (tid < 64) {
        const float2 lam = ((const float2*)(p.ws() + OFF_LAML))[g * 64 + tid];
        float sre = 0.f, sim = 0.f;
        for (int c = 0; c < 128; ++c) {
            const bf16_t hr = f2bf(sre), hi = f2bf(sim);
            SP[c * 256 + tid] = hr; SP[c * 256 + 64 + tid] = hi;
            SP[c * 256 + 128 + tid] = f2bf(sre - bf2f(hr)); SP[c * 256 + 192 + tid] = f2bf(sim - bf2f(hi));
            const float er = E[c * 128 + tid], ei = E[c * 128 + 64 + tid];
            const float nr = lam.x * sre - lam.y * sim + er, ni = lam.x * sim + lam.y * sre + ei;
            sre = nr; sim = ni;
        }
    }
    __syncthreads();
    const float* dsk = (const float*)p.in(13) + l * 512 + g * 16;
    bf16_t* GY = (bf16_t*)(p.ws() + OFF_GC) + (size_t)g * T_ * 16;
    for (int nt = 0; nt < 4; ++nt) {
        f32x4 acc[4][4]; zero_acc<4>(acc);
        af.n1 = 2 * (nt + 1);
        SsmBF bf; bf.n1 = af.n1; bf.bb = p.ws() + OFF_SBT + (size_t)(g * 512 + nt * 128) * 768 * 2;
#pragma unroll
        for (int i = 0; i < 4; ++i) bf.pb[i] = (unsigned)((sr + 32 * i) * 768 + sq * 8) * 2u;
        gemm_core<128>(acc, af.n1 + 4, af, bf, lds);
        EPI_VARS(128)
#pragma unroll
        for (int m = 0; m < 4; ++m) {
            const int c = EPI_ROW(128, m);
#pragma unroll
            for (int n = 0; n < 4; ++n) {
                const int col = nt * 128 + EPI_COL(n), i = col >> 4, pp = col & 15;
                const size_t tok = (size_t)b * 4096 + c * 32 + i;
                const f32x4 u = ld_bf4((const bf16_t*)U + tok * 512 + g * 16 + pp);
                const f32x4 d = *(const f32x4*)(dsk + pp);
                const f32x4 y = acc[m][n] + d * u;
                st_bf4(GY + tok * 16 + pp, (f32x4){gelu_tanh(y[0]), gelu_tanh(y[1]), gelu_tanh(y[2]), gelu_tanh(y[3])});
            }
        }
    }
}
DEV void phase_c(int l, unsigned* qctr, LAS char* lds) {
    LAS int* slot = (LAS int*)(lds + LDS_WORK);
    for (;;) {
        const int it = next_item(qctr, slot);
        if (it >= 256 + 2048) break;
        if (it < 256) ssm_item(l, it >> 3, it & 7, lds);
        else { const int a = it - 256, qb = 31 - (a >> 6), bh = a & 63; attn_item(bh >> 3, bh & 7, qb, lds); }
    }
}

struct GyAF { const char* base; unsigned off[4];
    DEV const char* operator()(int step, int i) const { return base + (off[i] + (unsigned)step * (unsigned)(4 * T_ * 32)); } };
DEV void pd1_tile(int l, int mt, int nt, LAS char* lds) {
    const KA p = get_ka();
    const char* wl = p.ws() + OFF_W + (size_t)l * W_LAYER;
    f32x4 acc[4][4]; zero_acc<4>(acc);
    GyAF af; { const int _t = tidx(); const int r = stage_row(_t), q = stage_q(_t); af.base = p.ws() + OFF_GC + (size_t)mt * 128 * 32;
#pragma unroll
        for (int i = 0; i < 4; ++i) af.off[i] = (unsigned)(r + 32 * i) * 32u + (unsigned)(q >> 1) * (unsigned)(T_ * 32) + (q & 1) * 16; }
    const RowsF<4> bf = mk_rows<4>(wl + W_GLU, 1024, nt * 128);
    gemm_core<128>(acc, 8, af, bf, lds);
    EPI_VARS(128)
    bf16_t* GO = (bf16_t*)(p.ws() + OFF_USSM);
#pragma unroll
    for (int m = 0; m < 4; ++m) {
        const int row = mt * 128 + EPI_ROW(128, m);
#pragma unroll
        for (int n = 0; n < 2; ++n) {
            const f32x4 v = acc[m][n], gte = acc[m][n + 2];
            const int col = nt * 64 + _wc * 32 + n * 16 + _fq * 4;
            st_bf4(GO + (size_t)row * 512 + col, (f32x4){v[0] * sigmoidf_(gte[0]), v[1] * sigmoidf_(gte[1]), v[2] * sigmoidf_(gte[2]), v[3] * sigmoidf_(gte[3])});
        }
    }
}
DEV void pd2_tile(int l, int mt, int nt, LAS char* lds) {
    const KA p = get_ka();
    const char* wl = p.ws() + OFF_W + (size_t)l * W_LAYER;
    f32x4 mg[4][4]; zero_acc<4>(mg);
    const RowsF<4> ah = mk_rows<4>(p.ws() + OFF_H, 2048, mt * 128);
#ifndef DBG_BRMASK
#define DBG_BRMASK 7
#endif
#pragma unroll 1
    for (int br = 0; br < 3; ++br) {
        if (!((DBG_BRMASK >> br) & 1)) continue;
        u32x2* park = (u32x2*)(p.ws() + OFF_E + (size_t)blockIdx.x * 32768) + tidx();
        {
            f32x4 acc[4][4]; zero_acc<4>(acc);
            const void* abase = br == 0 ? (const void*)(p.ws() + OFF_GB) : br == 1 ? (const void*)(p.ws() + OFF_USSM) : (const void*)(p.ws() + OFF_XC);
            const RowsF<4> af = mk_rows<4>(abase, 1024, mt * 128);
            const RowsF<4> bf = mk_rows<4>(wl + W_UPC + (size_t)br * 1024 * 512 * 2, 1024, nt * 128);
            gemm_core<128>(acc, 8, af, bf, lds);
#pragma unroll
            for (int m = 0; m < 4; ++m)
#pragma unroll
                for (int n = 0; n < 4; ++n) { u32x2 w; w.x = pk2(acc[m][n][0], acc[m][n][1]); w.y = pk2(acc[m][n][2], acc[m][n][3]); park[(m * 4 + n) * 256] = w; }
        }
        {
            f32x4 acc[4][4]; zero_acc<4>(acc);
            const RowsF<4> bf = mk_rows<4>(wl + W_G, 2048, br * 1024 + nt * 128);
            gemm_core<128>(acc, 16, ah, bf, lds);
#pragma unroll
            for (int m = 0; m < 4; ++m)
#pragma unroll
                for (int n = 0; n < 4; ++n) {
                    const f32x4 g = acc[m][n];
                    const u32x2 w = park[(m * 4 + n) * 256];
                    const f32x4 y = (f32x4){bflo(w.x), bfhi(w.x), bflo(w.y), bfhi(w.y)};
                    mg[m][n] += (f32x4){sigmoidf_(g[0]) * y[0], sigmoidf_(g[1]) * y[1], sigmoidf_(g[2]) * y[2], sigmoidf_(g[3]) * y[3]};
                }
        }
    }
    EPI_VARS(128)
    bf16_t* MG = (bf16_t*)(p.ws() + OFF_MERGED);
#pragma unroll
    for (int m = 0; m < 4; ++m)
#pragma unroll
        for (int n = 0; n < 4; ++n) {
#if defined(DBG_PD2OUT)
            *(f32x4*)(p.out() + (size_t)(mt * 128 + EPI_ROW(128, m)) * 1024 + nt * 128 + EPI_COL(n)) = mg[m][n];
#endif
            st_bf4(MG + (size_t)(mt * 128 + EPI_ROW(128, m)) * 1024 + nt * 128 + EPI_COL(n), mg[m][n]);
        }
}
DEV void pd3_strip(int l, int st, LAS char* lds) {
    const KA p = get_ka();
    const char* wl = p.ws() + OFF_W + (size_t)l * W_LAYER;
    const int tid = tidx(), lane = tid & 63, wid = tid >> 6;
    const int row0 = st * 64, b = row0 >> 12;
    const float* ada = (const float*)(p.ws() + OFF_ADA) + ((size_t)l * 8 + b) * 6144;
    const float* xin = l == 0 ? (const float*)p.in(0) : (const float*)p.out();
    float* xout = p.out();
    const RowsF<2> am = mk_rows<2>(p.ws() + OFF_MERGED, 2048, row0);
    for (int nt = 0; nt < 8; ++nt) {
        f32x4 acc[2][4]; zero_acc<2>(acc);
        const RowsF<4> bf = mk_rows<4>(wl + W_O, 2048, nt * 128);
        gemm_core<64>(acc, 16, am, bf, lds);
        EPI_VARS(64)
#pragma unroll
        for (int m = 0; m < 2; ++m) {
            const int row = row0 + EPI_ROW(64, m);
#pragma unroll
            for (int n = 0; n < 4; ++n) {
                const int col = nt * 128 + EPI_COL(n);
                const f32x4 xv = *(const f32x4*)(xin + (size_t)row * 1024 + col);
                const f32x4 g1 = *(const f32x4*)(ada + 2048 + col);
                *(f32x4*)(xout + (size_t)row * 1024 + col) = xv * ALPHA_ + g1 * acc[m][n];
            }
        }
    }
    __syncthreads();
    {
        const float* lng = (const float*)p.in(25) + (l * 2 + 0) * 1024; const float* lnb = (const float*)p.in(26) + (l * 2 + 0) * 1024;
        bf16_t* H = (bf16_t*)(p.ws() + OFF_H);
        for (int rr = wid; rr < 64; rr += 4) {
            const int row = row0 + rr;
            f32x4 v[4];
#pragma unroll
            for (int j = 0; j < 4; ++j) v[j] = *(const f32x4*)(xout + (size_t)row * 1024 + 4 * lane + 256 * j);
            ln_finish_row(v, lane, lng, lnb, xout + (size_t)row * 1024, ada + 3072, ada + 4096, H + (size_t)row * 1024);
        }
    }
    __syncthreads();
    {
        f32x4 acc[2][4]; zero_acc<2>(acc);
        RowsWrapF<2> ah; { const RowsF<2> t = mk_rows<2>(p.ws() + OFF_H, 2048, row0); ah.base = t.base; ah.off[0] = t.off[0]; ah.off[1] = t.off[1]; }
        const RowsF<4> bf = mk_rows<4>(p.ws() + OFF_WR, 4096, 0);
        gemm_core<64>(acc, 32, ah, bf, lds);
        LAS float* lg = (LAS float*)lds;
        EPI_VARS(64)
        if (_wc == 0) {
#pragma unroll
            for (int m = 0; m < 2; ++m)
#pragma unroll
                for (int n = 0; n < 2; ++n)
#pragma unroll
                    for (int j = 0; j < 4; ++j) lg[EPI_ROW(64, m) * 33 + n * 16 + _fq * 4 + j] = acc[m][n][j];
        }
        __syncthreads();
        if (tid < 64) {
            const float* rb = (const float*)p.in(28);
            float sc[32], sel[32];
#pragma unroll
            for (int e = 0; e < 32; ++e) { sc[e] = sigmoidf_(lg[tid * 33 + e]); sel[e] = sc[e] + rb[e]; }
            int bg = 0; float bgs = -INFINITY;
#pragma unroll
            for (int g = 0; g < 8; ++g) {
                float m1 = -INFINITY, m2 = -INFINITY;
#pragma unroll
                for (int j = 0; j < 4; ++j) { const float v = sel[g * 4 + j]; if (v > m1) { m2 = m1; m1 = v; } else if (v > m2) m2 = v; }
                const float gs = m1 + m2;
                if (gs > bgs) { bgs = gs; bg = g; }
            }
            int e1 = 0, e2 = 0; float v1 = -INFINITY, v2 = -INFINITY, s1 = 0.f, s2 = 0.f;
#pragma unroll
            for (int g = 0; g < 8; ++g) if (g == bg) {
#pragma unroll
                for (int j = 0; j < 4; ++j) { const float v = sel[g * 4 + j], s = sc[g * 4 + j];
                    if (v > v1) { v2 = v1; e2 = e1; s2 = s1; v1 = v; e1 = g * 4 + j; s1 = s; } else if (v > v2) { v2 = v; e2 = g * 4 + j; s2 = s; } }
            }
            const int tok = row0 + tid; const float inv = 1.f / (s1 + s2);
            float* rw = (float*)(p.ws() + OFF_RW); rw[tok * 2] = s1 * inv; rw[tok * 2 + 1] = s2 * inv;
            ((unsigned*)(p.ws() + OFF_ROUTE))[tok] = (unsigned)e1 | ((unsigned)e2 << 8);
        }
        __syncthreads();
    }
}

DEV void pd4_item(int l, int e, LAS char* lds) {
    const KA p = get_ka();
    const int tid = tidx(), lane = tid & 63, w = tid >> 6;
    LAS int* wcnt = (LAS int*)lds;
    const unsigned* route = (const unsigned*)(p.ws() + OFF_ROUTE) + w * 8192 + lane * 4;
    unsigned* list = (unsigned*)(p.ws() + OFF_LIST) + (size_t)e * T_;
    int c = 0;
    for (int it = 0; it < 32; ++it) {
        const u32x4 r = *(const u32x4*)(route + it * 256);
        const unsigned rr[4] = {r.x, r.y, r.z, r.w};
#pragma unroll
        for (int j = 0; j < 4; ++j) c += ((int)(rr[j] & 255u) == e || (int)((rr[j] >> 8) & 255u) == e) ? 1 : 0;
    }
    c = (int)wave_sum((float)c);
    __syncthreads();
    if (lane == 0) wcnt[w] = c;
    __syncthreads();
    int off = 0, total = 0;
    for (int k = 0; k < 4; ++k) { const int v = wcnt[k]; if (k < w) off += v; total += v; }
    if (tid == 0) ((unsigned*)(p.ws() + OFF_CTRL))[CW_CNT + (l * 32 + e) * 32] = (unsigned)total;
    for (int it = 0; it < 32; ++it) {
        const u32x4 r = *(const u32x4*)(route + it * 256);
        const unsigned rr[4] = {r.x, r.y, r.z, r.w};
#pragma unroll
        for (int j = 0; j < 4; ++j) {
            const int m0 = (int)(rr[j] & 255u) == e, m1 = (int)((rr[j] >> 8) & 255u) == e;
            const unsigned long long bal = __ballot(m0 || m1);
            const int rank = __popcll(bal & ((1ull << lane) - 1ull));
            if (m0 || m1) list[off + rank] = (unsigned)(w * 8192 + it * 256 + lane * 4 + j) * 2u + (m1 ? 1u : 0u);
            off += __popcll(bal);
        }
    }
    __syncthreads();
}

DEV void pe_item(int l, int e, int rb, int padrow0, int count, LAS char* lds) {
    const KA p = get_ka();
    const int tid = tidx(); const int sr = stage_row(tid), sq = stage_q(tid);
    const unsigned* list = (const unsigned*)(p.ws() + OFF_LIST) + (size_t)(e < 0 ? 0 : e) * T_ + rb * 128;
    const int nvalid = e < 0 ? 128 : min(128, count - rb * 128);
    const char* wl = p.ws() + OFF_W + (size_t)l * W_LAYER;
    const char* w13 = e < 0 ? wl + W_S13 : p.ws() + OFF_E13 + (size_t)e * 512 * 1024 * 2;
    const char* w2 = e < 0 ? wl + W_S2 : p.ws() + OFF_E2 + (size_t)e * 1024 * 256 * 2;
    bf16_t* mid = e < 0 ? (bf16_t*)(p.ws() + OFF_MIDS) + (size_t)rb * 128 * 256 : (bf16_t*)(p.ws() + OFF_MIDR) + (size_t)padrow0 * 256;
    RowsF<4> ah; ah.base = p.ws() + OFF_H;
#pragma unroll
    for (int i = 0; i < 4; ++i) {
        const int row = sr + 32 * i;
        int tok;
        if (e < 0) tok = rb * 128 + row; else tok = (int)(list[row < nvalid ? row : 0] >> 1);
        ah.off[i] = (unsigned)tok * 2048u + sq * 16;
    }
    for (int nt = 0; nt < 4; ++nt) {
        f32x4 acc[4][4]; zero_acc<4>(acc);
        const RowsF<4> bf = mk_rows<4>(w13, 2048, nt * 128);
        gemm_core<128>(acc, 16, ah, bf, lds);
        EPI_VARS(128)
#pragma unroll
        for (int m = 0; m < 4; ++m) {
            const int row = EPI_ROW(128, m);
#pragma unroll
            for (int n = 0; n < 2; ++n) {
                const f32x4 a = acc[m][n], g = acc[m][n + 2];
                const int col = nt * 64 + _wc * 32 + n * 16 + _fq * 4;
                st_bf4(mid + (size_t)row * 256 + col, (f32x4){siluf_(a[0]) * g[0], siluf_(a[1]) * g[1], siluf_(a[2]) * g[2], siluf_(a[3]) * g[3]});
            }
        }
    }
    __syncthreads();
    const RowsF<4> am = mk_rows<4>(mid, 512, 0);
    const float* rw = (const float*)(p.ws() + OFF_RW);
    EPI_VARS(128)
    size_t orow[4]; float ow[4];
#pragma unroll
    for (int m = 0; m < 4; ++m) {
        const int row = EPI_ROW(128, m);
        if (e < 0) { orow[m] = (size_t)(rb * 128 + row); ow[m] = 1.f; }
        else if (row < nvalid) { const unsigned en = list[row]; orow[m] = en; ow[m] = rw[en]; }
        else { orow[m] = 0; ow[m] = 0.f; }
    }
    bf16_t* outb = e < 0 ? (bf16_t*)(p.ws() + OFF_SHOUT) : (bf16_t*)(p.ws() + OFF_ROUT);
    for (int nt = 0; nt < 8; ++nt) {
        f32x4 acc[4][4]; zero_acc<4>(acc);
        const RowsF<4> bf = mk_rows<4>(w2, 512, nt * 128);
        gemm_core<128>(acc, 4, am, bf, lds);
#pragma unroll
        for (int m = 0; m < 4; ++m) {
            if (EPI_ROW(128, m) < nvalid) {
#pragma unroll
                for (int n = 0; n < 4; ++n) st_bf4(outb + orow[m] * 1024 + nt * 128 + EPI_COL(n), acc[m][n] * ow[m]);
            }
        }
    }
    (void)tid;
}
DEV void phase_e(int l, unsigned* qctr, LAS char* lds) {
    const KA p = get_ka();
    LAS int* slot = (LAS int*)(lds + LDS_WORK);
    LAS int* pre = slot + 4;
    const int tid = threadIdx.x;
    const unsigned* cnt = (const unsigned*)(p.ws() + OFF_CTRL) + CW_CNT + l * 32 * 32;
    if (tid == 0) { int a = 0; for (int e = 0; e < 32; ++e) { const int c = (int)cnt[e * 32]; pre[e] = a; a += (c + 127) >> 7; } pre[32] = a; }
    __syncthreads();
    const int nrb = pre[32];
    for (;;) {
        const int it = next_item(qctr, slot);
        if (it >= nrb + 256) break;
        if (it < nrb) {
            int e = 0;
            for (int k = 0; k < 32; ++k) if (it >= pre[k + 1]) e = k + 1;
            const int rb = it - pre[e];
            pe_item(l, e, rb, it * 128, (int)cnt[e * 32], lds);
        } else pe_item(l, -1, it - nrb, 0, 0, lds);
    }
}

DEV void phase_f(int l) {
    const KA p = get_ka();
    const int lane = threadIdx.x & 63, gw = blockIdx.x * 4 + (threadIdx.x >> 6), ngw = gridDim.x * 4;
    const bf16_t* R = (const bf16_t*)(p.ws() + OFF_ROUT); const bf16_t* SH = (const bf16_t*)(p.ws() + OFF_SHOUT);
    const float* lng = (const float*)p.in(25) + (l * 2 + 1) * 1024; const float* lnb = (const float*)p.in(26) + (l * 2 + 1) * 1024;
    bf16_t* H = (bf16_t*)(p.ws() + OFF_H);
    for (int row = gw; row < T_; row += ngw) {
        const int b = row >> 12;
        const float* ada = (const float*)(p.ws() + OFF_ADA) + ((size_t)l * 8 + b) * 6144;
        f32x4 v[4];
#pragma unroll
        for (int j = 0; j < 4; ++j) {
            const int col = 4 * lane + 256 * j;
            const f32x4 y = ld_bf4(R + (size_t)row * 2048 + col) + ld_bf4(R + (size_t)row * 2048 + 1024 + col) + ld_bf4(SH + (size_t)row * 1024 + col);
            const f32x4 xv = *(const f32x4*)(p.out() + (size_t)row * 1024 + col);
            const f32x4 g2 = *(const f32x4*)(ada + 5120 + col);
            v[j] = xv * ALPHA_ + g2 * y;
        }
        if (l + 1 < NL_) {
            const float* ada2 = (const float*)(p.ws() + OFF_ADA) + ((size_t)(l + 1) * 8 + b) * 6144;
            ln_finish_row(v, lane, lng, lnb, p.out() + (size_t)row * 1024, ada2 + 0, ada2 + 1024, H + (size_t)row * 1024);
        } else ln_finish_row(v, lane, lng, lnb, p.out() + (size_t)row * 1024, nullptr, nullptr, nullptr);
    }
}

DEV void grid_barrier(cg::grid_group& g) {
    asm volatile("s_waitcnt vmcnt(0) lgkmcnt(0)" ::: "memory");
    __syncthreads();
    g.sync();
    if (threadIdx.x == 0) { __builtin_amdgcn_fence(__ATOMIC_ACQUIRE, "agent"); asm volatile("s_waitcnt vmcnt(0)" ::: "memory"); }
    __syncthreads();
}

#ifndef DBG_STOP
#define DBG_STOP 0
#endif
#ifndef DBG_L
#define DBG_L 0
#endif
DEV void dbg_dump(size_t off) {
    const KA p = get_ka();
    const bf16_t* src = (const bf16_t*)(p.ws() + off); float* out = p.out();
    for (size_t i = (size_t)blockIdx.x * 256 + threadIdx.x; i < (size_t)T_ * 1024 / 4; i += (size_t)gridDim.x * 256) {
        const f32x4 v = ld_bf4(src + i * 4); *(f32x4*)(out + i * 4) = v;
    }
}
#define DBG_AT(k, off) if (DBG_STOP == (k) && l == DBG_L) { dbg_dump(off); return; }

__global__ void __launch_bounds__(256, 2) fwd_megakernel(Params pk) {
    extern __shared__ __attribute__((aligned(16))) unsigned char smem[];
    LAS char* lds = (LAS char*)smem;
    cg::grid_group grid = cg::this_grid();
    const int nb = gridDim.x, bid = blockIdx.x;
    phase0(lds);
    grid_barrier(grid);
    phase_lnmod0();
    grid_barrier(grid);
    { const int l = 0; DBG_AT(20, OFF_H) DBG_AT(21, OFF_W) }
#pragma unroll 1
    for (int l = 0; l < NL_; ++l) {
        phase_a(l, lds);
        grid_barrier(grid);
        DBG_AT(1, OFF_XC) DBG_AT(2, OFF_GB) DBG_AT(3, OFF_CQ)
        phase_b(l, lds);
        grid_barrier(grid);
        DBG_AT(4, OFF_Q) DBG_AT(5, OFF_KN + 16 * MiB)
        phase_c(l, (unsigned*)(get_ka().ws() + OFF_CTRL) + CW_QUEUE + 64 * (2 * l), lds);
        grid_barrier(grid);
        DBG_AT(6, OFF_XC)
#pragma unroll 1
        for (int it = bid; it < 2048; it += nb) pd1_tile(l, it >> 3, it & 7, lds);
        grid_barrier(grid);
        DBG_AT(7, OFF_GB)
#pragma unroll 1
        for (int it = bid; it < 2048; it += nb) pd2_tile(l, it >> 3, it & 7, lds);
        grid_barrier(grid);
        if (DBG_STOP == 8 && l == DBG_L) return;
#pragma unroll 1
        for (int it = bid; it < 512; it += nb) pd3_strip(l, it, lds);
        grid_barrier(grid);
        DBG_AT(9, OFF_H)
        if (DBG_STOP == 10 && l == DBG_L) return;
#pragma unroll 1
        for (int it = bid; it < 32; it += nb) pd4_item(l, it, lds);
        grid_barrier(grid);
        phase_e(l, (unsigned*)(get_ka().ws() + OFF_CTRL) + CW_QUEUE + 64 * (2 * l + 1), lds);
        grid_barrier(grid);
        DBG_AT(11, OFF_ROUT) DBG_AT(12, OFF_SHOUT)
        phase_f(l);
        grid_barrier(grid);
    }
}

extern "C" void kernel_launch(void* const* d_in, const int* in_sizes, int n_in, void* d_out, int out_size, void* d_ws, size_t ws_size, hipStream_t stream) {
    static int grid_blocks = 0;
    if (grid_blocks == 0) {
        if (n_in != 35 || ws_size < OFF_END) { fprintf(stderr, "kernel_launch: unexpected n_in %d or ws_size %zu (need %zu)\n", n_in, ws_size, (size_t)OFF_END); grid_blocks = -1; return; }
        int dev = 0, cus = 0, per_cu = 0;
        (void)hipGetDevice(&dev);
        (void)hipDeviceGetAttribute(&cus, hipDeviceAttributeMultiprocessorCount, dev);
        if (hipFuncSetAttribute((const void*)fwd_megakernel, hipFuncAttributeMaxDynamicSharedMemorySize, LDS_BYTES) != hipSuccess) { fprintf(stderr, "hipFuncSetAttribute failed\n"); grid_blocks = -1; return; }
        if (hipOccupancyMaxActiveBlocksPerMultiprocessor(&per_cu, (const void*)fwd_megakernel, 256, LDS_BYTES) != hipSuccess || per_cu < 1) { fprintf(stderr, "occupancy query failed\n"); grid_blocks = -1; return; }
        if (per_cu > 2) per_cu = 2;
        grid_blocks = cus * per_cu;
        fprintf(stderr, "kernel_launch: %d CUs x %d blocks\n", cus, per_cu);
    }
    if (grid_blocks < 0) return;
    Params p{};
    for (int i = 0; i < 35; ++i) p.in[i] = d_in[i];
    p.out = (float*)d_out; p.ws = (char*)d_ws;
    void* args[] = {&p};
    hipError_t e = hipLaunchCooperativeKernel((void*)fwd_megakernel, dim3(grid_blocks), dim3(256), args, LDS_BYTES, stream);
    if (e != hipSuccess) fprintf(stderr, "cooperative launch failed: %s (grid %d)\n", hipGetErrorString(e), grid_blocks);
}
```

```cpp
#include <hip/hip_runtime.h>
#include <hip/hip_cooperative_groups.h>
#include <cstdio>
#include <cstdint>
namespace cg = cooperative_groups;

typedef unsigned short bf16_t;
typedef short bf16x8 __attribute__((ext_vector_type(8)));
typedef float f32x4 __attribute__((ext_vector_type(4)));
typedef float f32x16 __attribute__((ext_vector_type(16)));
typedef unsigned u32x4 __attribute__((ext_vector_type(4)));
typedef unsigned u32x2 __attribute__((ext_vector_type(2)));
#define LAS __attribute__((address_space(3)))
#define GAS __attribute__((address_space(1)))
#define DEV __device__ __forceinline__

constexpr int T_ = 32768, D_ = 1024, S_ = 4096, NB_ = 8, NH_ = 8, NL_ = 2;
constexpr int NIN_ = 5536, NMIX_ = 2464;
constexpr float ALPHA_ = 1.41421356237f;
constexpr float QSCALE_ = 0.10206207261596577f * 1.4426950408889634f;

constexpr size_t MiB = 1u << 20;
constexpr size_t OFF_CTRL = 0;
constexpr size_t OFF_ADA = 64 * 1024;
constexpr size_t OFF_ROUTE = 512 * 1024;
constexpr size_t OFF_RW = 768 * 1024;
constexpr size_t OFF_CS = 1 * MiB;
constexpr size_t OFF_LIST = 5 * MiB;
constexpr size_t OFF_LAML = 9 * MiB;
constexpr size_t OFF_WR = 9 * MiB + 512 * 1024;
constexpr size_t OFF_W = 10 * MiB;
constexpr size_t W_IN = 0;
constexpr size_t W_G = W_IN + 2560 * 1024 * 2;
constexpr size_t W_GLU = W_G + 3072 * 1024 * 2;
constexpr size_t W_UQ = W_GLU + 1024 * 512 * 2;
constexpr size_t W_UK = W_UQ + 1024 * 256 * 2;
constexpr size_t W_UV = W_UK + 512 * 128 * 2;
constexpr size_t W_UPC = W_UV + 512 * 128 * 2;
constexpr size_t W_UPS = W_UPC + 1024 * 512 * 2;
constexpr size_t W_UPA = W_UPS + 1024 * 512 * 2;
constexpr size_t W_O = W_UPA + 1024 * 512 * 2;
constexpr size_t W_S13 = W_O + 1024 * 1024 * 2;
constexpr size_t W_S2 = W_S13 + 512 * 1024 * 2;
constexpr size_t W_LAYER = W_S2 + 1024 * 256 * 2;
constexpr size_t OFF_LATE = OFF_W + 2 * W_LAYER + (MiB - (2 * W_LAYER) % MiB) % MiB;
constexpr size_t OFF_E13 = OFF_LATE;
constexpr size_t OFF_E2 = OFF_E13 + 32 * MiB;
constexpr size_t OFF_SBT = OFF_E2 + 16 * MiB;
constexpr size_t OFF_SG = OFF_SBT + 24 * MiB;
constexpr size_t OFF_H = OFF_SG + 4 * MiB;
constexpr size_t OFF_ACT = OFF_H + 64 * MiB;
constexpr size_t OFF_XC = OFF_ACT;
constexpr size_t OFF_GC = OFF_XC + 32 * MiB;
constexpr size_t OFF_GB = OFF_GC + 32 * MiB;
constexpr size_t OFF_USSM = OFF_GB + 32 * MiB;
constexpr size_t OFF_CQ = OFF_USSM + 32 * MiB;
constexpr size_t OFF_CKV = OFF_CQ + 16 * MiB;
constexpr size_t OFF_KR = OFF_CKV + 8 * MiB;
constexpr size_t OFF_Q = OFF_KR + 2 * MiB;
constexpr size_t OFF_KN = OFF_Q + 48 * MiB;
constexpr size_t OFF_KRP = OFF_KN + 32 * MiB;
constexpr size_t OFF_VT = OFF_KRP + 2 * MiB;
constexpr size_t OFF_E = OFF_VT + 32 * MiB;
constexpr size_t OFF_SPREV = OFF_E;
constexpr size_t OFF_H8 = OFF_E + 16 * MiB;
constexpr size_t OFF_END = OFF_H8 + 32 * MiB;
constexpr size_t OFF_SSQP = OFF_E;
constexpr size_t OFF_ROUT = OFF_ACT;
constexpr size_t OFF_SHOUT = OFF_ROUT + 128 * MiB;
constexpr size_t OFF_MIDR = OFF_SHOUT + 64 * MiB;
constexpr size_t OFF_MIDS = OFF_MIDR + 36 * MiB;
static_assert(OFF_MIDS + 16 * MiB <= OFF_END, "moe alias");
static_assert(OFF_END <= 512 * MiB, "ws");
constexpr size_t OFF_MERGED = OFF_Q;

constexpr int CW_QUEUE = 0;
constexpr int CW_CNT = 4096;
constexpr int CW_BAR = 8192;
constexpr int CTRL_BYTES = 65536;

constexpr int LDS_WORK = 73728;
constexpr int LDS_BYTES = LDS_WORK + 1024;

struct Params { const void* in[35]; float* out; char* ws; };
#define CAS __attribute__((address_space(4)))
struct KA {
    const CAS char* k;
    __device__ __forceinline__ const void* in(int i) const { return *(const void* const CAS*)(k + 8 * i); }
    __device__ __forceinline__ float* out() const { return *(float* const CAS*)(k + 8 * 35); }
    __device__ __forceinline__ char* ws() const { return *(char* const CAS*)(k + 8 * 36); }
};
__device__ __forceinline__ KA get_ka() { const CAS char* k = (const CAS char*)__builtin_amdgcn_kernarg_segment_ptr(); asm volatile("" : "+s"(k)); KA a; a.k = k; return a; }
__device__ __forceinline__ int tidx() { int t = threadIdx.x; asm volatile("" : "+v"(t)); return t; }

typedef float f32x2_t __attribute__((ext_vector_type(2)));
typedef __bf16 bf16x2_t __attribute__((ext_vector_type(2)));
DEV unsigned pk2(float lo, float hi) { const f32x2_t v = {lo, hi}; const bf16x2_t b = __builtin_convertvector(v, bf16x2_t); return __builtin_bit_cast(unsigned, b); }
typedef int v8i_t __attribute__((ext_vector_type(8)));
typedef int v4i_t __attribute__((ext_vector_type(4)));
constexpr float GY8_SCALE = 8.f, WL8_SCALE = 32.f;
constexpr float WI8_SCALE = 32.f;
constexpr float WE8_SCALE = 64.f, MID8_SCALE = 4.f;
constexpr float H8_SCALE = 4.f, WG8_SCALE = 64.f, MG8_SCALE = 8.f, WO8_SCALE = 64.f, WU8_SCALE = 64.f;
constexpr float BR8_SCALE[3] = {2.f, 8.f, 16.f};
DEV float clamp8(float v) { return fminf(fmaxf(v, -440.f), 440.f); }
DEV unsigned pk4_fp8(float a, float b, float c, float d) { int w = __builtin_amdgcn_cvt_pk_fp8_f32(a, b, 0, false); w = __builtin_amdgcn_cvt_pk_fp8_f32(c, d, w, true); return (unsigned)w; }
DEV float bflo(unsigned w) { return __uint_as_float(w << 16); }
DEV float bfhi(unsigned w) { return __uint_as_float(w & 0xffff0000u); }
DEV float bf2f(bf16_t v) { return __uint_as_float((unsigned)v << 16); }
DEV bf16_t f2bf(float f) { return (bf16_t)(pk2(f, 0.f) & 0xffffu); }
DEV float sigmoidf_(float x) { return __builtin_amdgcn_rcpf(1.f + __expf(-x)); }
DEV float siluf_(float x) { return x * sigmoidf_(x); }
DEV float gelu_tanh(float y) { const float z = 0.7978845608028654f * (y + 0.044715f * y * y * y); const float t = 1.f - 2.f * __builtin_amdgcn_rcpf(1.f + __expf(2.f * z)); return 0.5f * y * (1.f + t); }
DEV float shx(float v, int o) { return __int_as_float(__builtin_amdgcn_ds_bpermute((((int)tidx() & 63) ^ o) << 2, __float_as_int(v))); }
DEV float wave_sum(float v) {
#pragma unroll
    for (int o = 1; o < 64; o <<= 1) v += shx(v, o);
    return v;
}
DEV int next_item(unsigned* counter, LAS int* slot) {
    __syncthreads();
    if (tidx() == 0) *slot = (int)atomicAdd(counter, 1u);
    __syncthreads();
    return *slot;
}

template <int N> struct RowsF {
    const char* base; unsigned off[N];
    DEV const char* operator()(int step, int i) const { return base + (off[i] + (unsigned)step * 128u); }
};
template <int N> struct RowsWrapF {
    const char* base; unsigned off[N];
    DEV const char* operator()(int step, int i) const { return base + (off[i] + (unsigned)(step & 15) * 128u); }
};
DEV int stage_row(int tid) { return tid >> 3; }
DEV int stage_q(int tid) { return (tid & 7) ^ ((tid >> 4) & 7); }
template <int N> DEV RowsF<N> mk_rows(const void* base, unsigned pitch_bytes, int row0) {
    RowsF<N> f; const int _t = tidx(); const int r = stage_row(_t), q = stage_q(_t);
    f.base = (const char*)base + (size_t)row0 * pitch_bytes;
#pragma unroll
    for (int i = 0; i < N; ++i) f.off[i] = (unsigned)(r + 32 * i) * pitch_bytes + q * 16;
    return f;
}

template <int BM, class AF, class BF>
DEV void stage_tile(const AF& af, const BF& bf, int step, LAS char* lds, int buf) {
    constexpr int NA = BM / 32, STAGE = BM * 128 + 16384;
    LAS char* _s = lds + buf * STAGE + (tidx() >> 6) * 1024;
#pragma unroll
    for (int _i = 0; _i < NA; ++_i) __builtin_amdgcn_global_load_lds((const GAS unsigned*)af(step, _i), (LAS unsigned*)(_s + _i * 4096), 16, 0, 0);
#pragma unroll
    for (int _i = 0; _i < 4; ++_i) __builtin_amdgcn_global_load_lds((const GAS unsigned*)bf(step, _i), (LAS unsigned*)(_s + BM * 128 + _i * 4096), 16, 0, 0);
}
struct NoNext { DEV void operator()(int) const {} DEV bool operator()(int, int) const { return false; } };
template <class AF, class BF, int BM = 128> struct NextT {
    AF a; BF b; bool valid; LAS char* lds;
    DEV void operator()(int buf) const { if (valid) stage_tile<BM>(a, b, 0, lds, buf); }
};
struct NextRows {
    const void* abase; const void* bbase; unsigned apitch, bpitch; int arow0, brow0; bool valid; LAS char* lds;
    DEV void operator()(int buf) const { if (valid) stage_tile<128>(mk_rows<4>(abase, apitch, arow0), mk_rows<4>(bbase, bpitch, brow0), 0, lds, buf); }    DEV bool operator()(int step, int buf) const { if (valid) stage_tile<128>(mk_rows<4>(abase, apitch, arow0), mk_rows<4>(bbase, bpitch, brow0), step, lds, buf); return valid; }
};
template <int BM, class AF, class BF, class NX>
DEV void gemm_core(f32x4 (&acc)[BM / 32][4], const int nsteps, const AF& af, const BF& bf, LAS char* lds, int& buf, const bool primed, const NX& next) {
    constexpr int MI = BM / 32, STAGE = BM * 128 + 16384;
    const int tid = tidx(), lane = tid & 63, wid = tid >> 6, wr = wid >> 1, wc = wid & 1, fr = lane & 15, fq = lane >> 4;
    const int sw = (fr >> 1) & 7;
    const int a_off = (wr * (BM / 2) + fr) * 128, b_off = BM * 128 + (wc * 64 + fr) * 128;
    const int o0 = (fq ^ sw) * 16, o1 = ((4 + fq) ^ sw) * 16;
    if (!primed) {
        stage_tile<BM>(af, bf, 0, lds, buf);
        asm volatile("s_waitcnt vmcnt(0)" ::: "memory");
        __syncthreads();
    }
    for (int t = 0; t < nsteps; ++t) {
        if (t + 1 < nsteps) stage_tile<BM>(af, bf, t + 1, lds, buf ^ 1); else next(buf ^ 1);
        const LAS char* sa = lds + buf * STAGE + a_off;
        const LAS char* sb = lds + buf * STAGE + b_off;
#pragma unroll
        for (int ks = 0; ks < 2; ++ks) {
            const int off = ks ? o1 : o0;
            bf16x8 fa[MI], fb[4];
#pragma unroll
            for (int m = 0; m < MI; ++m) fa[m] = *(const LAS bf16x8*)(sa + m * 2048 + off);
#pragma unroll
            for (int n = 0; n < 4; ++n) fb[n] = *(const LAS bf16x8*)(sb + n * 2048 + off);
#pragma unroll
            for (int m = 0; m < MI; ++m)
#pragma unroll
                for (int n = 0; n < 4; ++n) acc[m][n] = __builtin_amdgcn_mfma_f32_16x16x32_bf16(fb[n], fa[m], acc[m][n], 0, 0, 0);
        }
        asm volatile("s_waitcnt vmcnt(0)" ::: "memory");
        __syncthreads();
        buf ^= 1;
    }
}
template <int BM, class AF, class BF, class NX>
DEV void gemm_core_f8(f32x4 (&acc)[BM / 32][4], const int nsteps, const AF& af, const BF& bf, LAS char* lds, int& buf, const bool primed, const NX& next) {
    constexpr int MI = BM / 32, STAGE = BM * 128 + 16384;
    const int tid = tidx(), lane = tid & 63, wid = tid >> 6, wr = wid >> 1, wc = wid & 1, fr = lane & 15, fq = lane >> 4;
    const int sw = (fr >> 1) & 7;
    const int a_off = (wr * (BM / 2) + fr) * 128, b_off = BM * 128 + (wc * 64 + fr) * 128;
    const int o0 = (fq ^ sw) * 16, o1 = ((4 + fq) ^ sw) * 16;
    if (!primed) {
        stage_tile<BM>(af, bf, 0, lds, buf);
        stage_tile<BM>(af, bf, 1, lds, buf ^ 1);
        asm volatile("s_waitcnt vmcnt(%0)" :: "n"(MI + 4) : "memory");
        __builtin_amdgcn_s_barrier();
    }
#pragma unroll 1
    for (int t = 0; t < nsteps; ++t) {
        const LAS char* sa = lds + buf * STAGE + a_off;
        const LAS char* sb = lds + buf * STAGE + b_off;
        v8i_t fa[MI], fb[4];
#pragma unroll
        for (int n = 0; n < 4; ++n) { const v4i_t lo = *(const LAS v4i_t*)(sb + n * 2048 + o0), hi = *(const LAS v4i_t*)(sb + n * 2048 + o1); fb[n] = (v8i_t){lo.x, lo.y, lo.z, lo.w, hi.x, hi.y, hi.z, hi.w}; }
#pragma unroll
        for (int m = 0; m < MI; ++m) { const v4i_t lo = *(const LAS v4i_t*)(sa + m * 2048 + o0), hi = *(const LAS v4i_t*)(sa + m * 2048 + o1); fa[m] = (v8i_t){lo.x, lo.y, lo.z, lo.w, hi.x, hi.y, hi.z, hi.w}; }
        asm volatile("s_waitcnt lgkmcnt(0)" ::: "memory");
        __builtin_amdgcn_s_barrier();
        bool issued = true;
        if (t + 2 < nsteps) stage_tile<BM>(af, bf, t + 2, lds, buf); else issued = next(t + 2 - nsteps, buf);
#pragma unroll
        for (int m = 0; m < MI; ++m)
#pragma unroll
            for (int n = 0; n < 4; ++n) acc[m][n] = __builtin_amdgcn_mfma_scale_f32_16x16x128_f8f6f4(fb[n], fa[m], acc[m][n], 0, 0, 0, 0x7F7F7F7F, 0, 0x7F7F7F7F);
        if (issued) asm volatile("s_waitcnt vmcnt(%0)" :: "n"(MI + 4) : "memory"); else asm volatile("s_waitcnt vmcnt(0)" ::: "memory");
        __builtin_amdgcn_s_barrier();
        buf ^= 1;
    }
}
template <int BM, class AF, class BF>
DEV void gemm_core(f32x4 (&acc)[BM / 32][4], const int nsteps, const AF& af, const BF& bf, LAS char* lds) {
    int buf = 0; gemm_core<BM>(acc, nsteps, af, bf, lds, buf, false, NoNext());
}
DEV int vblock() { const int nb = gridDim.x, b = blockIdx.x; return (nb & 7) == 0 ? (b & 7) * (nb >> 3) + (b >> 3) : b; }
template <int MI> DEV void zero_acc(f32x4 (&acc)[MI][4]) {
#pragma unroll
    for (int m = 0; m < MI; ++m)
#pragma unroll
        for (int n = 0; n < 4; ++n) acc[m][n] = (f32x4){0.f, 0.f, 0.f, 0.f};
}
#define EPI_VARS(BM) const int _tq = tidx(); const int _lane = _tq & 63, _wid = _tq >> 6, _wr = _wid >> 1, _wc = _wid & 1, _fr = _lane & 15, _fq = _lane >> 4; (void)_wc; (void)_fq; (void)_fr; (void)_wr;
#define EPI_ROW(BM, m) (_wr * ((BM) / 2) + (m) * 16 + _fr)
#define EPI_COL(n) (_wc * 64 + (n) * 16 + _fq * 4)

DEV void st_bf4(bf16_t* dst, f32x4 v) { u32x2 w; w.x = pk2(v[0], v[1]); w.y = pk2(v[2], v[3]); *(u32x2*)dst = w; }
DEV f32x4 ld_bf4(const bf16_t* src) { const u32x2 w = *(const u32x2*)src; return (f32x4){bflo(w.x), bfhi(w.x), bflo(w.y), bfhi(w.y)}; }

template <class CP>
DEV void cvt_tile(const CP& colptr, int ld, const float* kscale, bf16_t* dst, int Kdst, int n0, int k0, LAS float* tile) {
    const int tid = tidx(), tx = tid & 63, ty = tid >> 6;
    const float* cp = colptr(n0 + tx);
    float tv[16];
#pragma unroll
    for (int i = 0; i < 16; ++i) tv[i] = cp ? cp[(size_t)(k0 + ty + 4 * i) * ld] : 0.f;
#pragma unroll
    for (int i = 0; i < 16; ++i) {
        const int k = ty + 4 * i;
        float v = tv[i];
        if (kscale) v *= kscale[k0 + k];
        tile[k * 65 + tx] = v;
    }
    __syncthreads();
#pragma unroll
    for (int j = 0; j < 2; ++j) {
        const int c = tid + 256 * j, row = c >> 3, kc = c & 7;
        const LAS float* s = tile + (kc * 8) * 65 + row;
        u32x4 o; o.x = pk2(s[0], s[65]); o.y = pk2(s[2 * 65], s[3 * 65]); o.z = pk2(s[4 * 65], s[5 * 65]); o.w = pk2(s[6 * 65], s[7 * 65]);
        *(u32x4*)(dst + (size_t)(n0 + row) * Kdst + k0 + kc * 8) = o;
    }
    __syncthreads();
}
template <class CP>
DEV void cvt_tile_f8(const CP& colptr, int ld, float scale, unsigned char* dst, int Kdst, int n0, int k0, LAS float* tile) {
    const int tid = tidx(), tx = tid & 63, ty = tid >> 6;
    const float* cp = colptr(n0 + tx);
    float tv[16];
#pragma unroll
    for (int i = 0; i < 16; ++i) tv[i] = cp ? cp[(size_t)(k0 + ty + 4 * i) * ld] : 0.f;
#pragma unroll
    for (int i = 0; i < 16; ++i) tile[(ty + 4 * i) * 65 + tx] = tv[i] * scale;
    __syncthreads();
    {
        const int row = tid >> 2, kc = tid & 3;
        const LAS float* sp = tile + (kc * 16) * 65 + row;
        u32x4 o;
        o.x = pk4_fp8(sp[0], sp[65], sp[2 * 65], sp[3 * 65]); o.y = pk4_fp8(sp[4 * 65], sp[5 * 65], sp[6 * 65], sp[7 * 65]);
        o.z = pk4_fp8(sp[8 * 65], sp[9 * 65], sp[10 * 65], sp[11 * 65]); o.w = pk4_fp8(sp[12 * 65], sp[13 * 65], sp[14 * 65], sp[15 * 65]);
        *(u32x4*)(dst + (size_t)(n0 + row) * Kdst + k0 + kc * 16) = o;
    }
    __syncthreads();
}
template <class CP>
DEV void cvt_tile_f8w(const CP& colptr, int ld, float scale, unsigned char* dst, int Kdst, int n0, int k0, LAS float* tile) {
    const int tid = tidx(), tx = tid & 63, ty = tid >> 6;
    const float* cp = colptr(n0 + tx);
#pragma unroll
    for (int h = 0; h < 2; ++h) {
        float tv[16];
#pragma unroll
        for (int i = 0; i < 16; ++i) tv[i] = cp ? cp[(size_t)(k0 + 64 * h + ty + 4 * i) * ld] : 0.f;
#pragma unroll
        for (int i = 0; i < 16; ++i) tile[(64 * h + ty + 4 * i) * 65 + tx] = tv[i] * scale;
    }
    __syncthreads();
#pragma unroll
    for (int j = 0; j < 2; ++j) {
        const int c = tid + 256 * j, row = c >> 3, kc = c & 7;
        const LAS float* sp = tile + (kc * 16) * 65 + row;
        u32x4 o;
        o.x = pk4_fp8(sp[0], sp[65], sp[2 * 65], sp[3 * 65]); o.y = pk4_fp8(sp[4 * 65], sp[5 * 65], sp[6 * 65], sp[7 * 65]);
        o.z = pk4_fp8(sp[8 * 65], sp[9 * 65], sp[10 * 65], sp[11 * 65]); o.w = pk4_fp8(sp[12 * 65], sp[13 * 65], sp[14 * 65], sp[15 * 65]);
        *(u32x4*)(dst + (size_t)(n0 + row) * Kdst + k0 + kc * 16) = o;
    }
    __syncthreads();
}
DEV void glu_map(int np, int& isgate, int& idx) { const int t = np >> 7, w = (np >> 6) & 1, within = np & 63; isgate = within >> 5; idx = t * 64 + w * 32 + (within & 31); }

DEV void cvt_early_item(int it, LAS char* lds) {
    const KA p = get_ka();
    LAS float* tile = (LAS float*)lds;
    constexpr int PER_LAYER = 2464;
    const int l = it / PER_LAYER; int r = it % PER_LAYER;
    char* wl = p.ws() + OFF_W + (size_t)l * W_LAYER;
    const float* w_in = (const float*)p.in(5) + (size_t)l * D_ * NIN_;
    if (r < 640) { const int nt = r / 16, kt = r % 16;
        cvt_tile_f8([&](int n) -> const float* { return n < NMIX_ ? w_in + n : nullptr; }, NIN_, WI8_SCALE, (unsigned char*)(wl + W_IN), 1024, nt * 64, kt * 64, tile); return; } r -= 640;
    if (r < 768) { const int nt = r / 16, kt = r % 16;
        cvt_tile_f8([&](int n) -> const float* { return w_in + NMIX_ + n; }, NIN_, WG8_SCALE, (unsigned char*)(wl + W_G), 1024, nt * 64, kt * 64, tile); return; } r -= 768;
    if (r < 128) { const int nt = r / 8, kt = r % 8; const float* w = (const float*)p.in(15) + (size_t)l * 512 * 1024;
        cvt_tile_f8([&](int n) -> const float* { int g, idx; glu_map(n, g, idx); return w + g * 512 + idx; }, 1024, WL8_SCALE, (unsigned char*)(wl + W_GLU), 512, nt * 64, kt * 64, tile); return; } r -= 128;
    if (r < 64) { const int nt = r / 4, kt = r % 4; const float* w = (const float*)p.in(17) + (size_t)l * 256 * 768;
        cvt_tile([&](int n) -> const float* { const int h = n >> 7, d = n & 127; if (d >= 96) return nullptr; int c = d; if (d >= 64) { const int i = (d - 64) >> 1, part = (d - 64) & 1; c = 64 + part * 16 + i; } return w + h * 96 + c; },
                 768, (const float*)p.in(16) + l * 256, (bf16_t*)(wl + W_UQ), 256, nt * 64, kt * 64, tile); return; } r -= 64;
    if (r < 16) { const int nt = r / 2, kt = r % 2; const float* w = (const float*)p.in(19) + (size_t)l * 128 * 512;
        cvt_tile([&](int n) -> const float* { return w + n; }, 512, (const float*)p.in(18) + l * 128, (bf16_t*)(wl + W_UK), 128, nt * 64, kt * 64, tile); return; } r -= 16;
    if (r < 16) { const int nt = r / 2, kt = r % 2; const float* w = (const float*)p.in(20) + (size_t)l * 128 * 512;
        cvt_tile([&](int n) -> const float* { return w + n; }, 512, (const float*)p.in(18) + l * 128, (bf16_t*)(wl + W_UV), 128, nt * 64, kt * 64, tile); return; } r -= 16;
    if (r < 384) { const int which = r / 128, rr = r % 128, nt = rr / 8, kt = rr % 8; const float* w = (const float*)p.in(21 + which) + (size_t)l * 512 * 1024;
        cvt_tile_f8([&](int n) -> const float* { return w + n; }, 1024, WU8_SCALE, (unsigned char*)(wl + W_UPC + (size_t)which * 1024 * 512 * 2), 512, nt * 64, kt * 64, tile); return; } r -= 384;
    if (r < 256) { const int nt = r / 16, kt = r % 16; const float* w = (const float*)p.in(24) + (size_t)l * 1024 * 1024;
        cvt_tile_f8([&](int n) -> const float* { return w + n; }, 1024, WO8_SCALE, (unsigned char*)(wl + W_O), 1024, nt * 64, kt * 64, tile); return; } r -= 256;
    if (r < 128) { const int nt = r / 16, kt = r % 16; const float* w1 = (const float*)p.in(32) + (size_t)l * 1024 * 256; const float* w3 = (const float*)p.in(33) + (size_t)l * 1024 * 256;
        cvt_tile_f8([&](int n) -> const float* { int g, idx; glu_map(n, g, idx); return (g ? w3 : w1) + idx; }, 256, WE8_SCALE, (unsigned char*)(wl + W_S13), 1024, nt * 64, kt * 64, tile); return; } r -= 128;
    { const int nt = r / 4, kt = r % 4; const float* w = (const float*)p.in(34) + (size_t)l * 256 * 1024;
        cvt_tile_f8([&](int n) -> const float* { return w + n; }, 1024, WE8_SCALE, (unsigned char*)(wl + W_S2), 256, nt * 64, kt * 64, tile); }
}
constexpr int NCVT_EARLY = 2 * 2464;
DEV void cvt_expert_item(int l, int it, LAS char* lds) {
    const KA p = get_ka();
    LAS float* tile = (LAS float*)lds;
    const int e = it / 96; int r = it % 96;
    if (r < 64) { const int nt = r >> 3, kt = r & 7;
        const float* w1 = (const float*)p.in(29) + ((size_t)l * 32 + e) * 1024 * 256; const float* w3 = (const float*)p.in(30) + ((size_t)l * 32 + e) * 1024 * 256;
        cvt_tile_f8w([&](int n) -> const float* { int g, idx; glu_map(n, g, idx); return (g ? w3 : w1) + idx; }, 256, WE8_SCALE, (unsigned char*)(p.ws() + OFF_E13) + (size_t)e * 512 * 1024, 1024, nt * 64, kt * 128, tile); return; }
    r -= 64;
    { const int nt = r >> 1, kt = r & 1; const float* w = (const float*)p.in(31) + ((size_t)l * 32 + e) * 256 * 1024;
        cvt_tile_f8w([&](int n) -> const float* { return w + n; }, 1024, WE8_SCALE, (unsigned char*)(p.ws() + OFF_E2) + (size_t)e * 1024 * 256, 256, nt * 64, kt * 128, tile); }
}

DEV void ada_item(int it, LAS char* lds) {
    const KA p = get_ka();
    LAS float* sc = (LAS float*)lds;
    LAS float* red = sc + 8192;
    const int tid = tidx(), l = it / 192, j0 = (it % 192) * 32, kq = tid >> 5, cj = tid & 31;
    const float* c = (const float*)p.in(1);
    for (int i = tid; i < 8192; i += 256) sc[i] = siluf_(c[i]);
    __syncthreads();
    const float* w = (const float*)p.in(3) + (size_t)l * 1024 * 6144 + j0 + cj;
    float a[8];
#pragma unroll
    for (int b = 0; b < 8; ++b) a[b] = 0.f;
#pragma unroll 16
    for (int k = kq * 128; k < kq * 128 + 128; ++k) {
        const float wv = w[(size_t)k * 6144];
#pragma unroll
        for (int b = 0; b < 8; ++b) a[b] += sc[b * 1024 + k] * wv;
    }
#pragma unroll
    for (int b = 0; b < 8; ++b) red[(kq * 32 + cj) * 8 + b] = a[b];
    __syncthreads();
    {
        const int b = tid >> 5, jj = tid & 31;
        float s = 0.f;
#pragma unroll
        for (int q = 0; q < 8; ++q) s += red[(q * 32 + jj) * 8 + b];
        ((float*)(p.ws() + OFF_ADA))[((size_t)l * 8 + b) * 6144 + j0 + jj] = s + ((const float*)p.in(4))[l * 6144 + j0 + jj];
    }
    __syncthreads();
}

DEV void ld_vec16(const float* pv, int lane, f32x4 (&o)[4]) {
#pragma unroll
    for (int j = 0; j < 4; ++j) o[j] = *(const f32x4*)(pv + 4 * lane + 256 * j);
}
template <bool AFF, bool MOD>
DEV void ln_row(f32x4 (&v)[4], const int lane, const f32x4 (&g)[4], const f32x4 (&bb)[4], float* xout_row, const f32x4 (&sc)[4], const f32x4 (&sh)[4], bf16_t* h_row, unsigned char* h8_row = nullptr) {
    float s = 0.f;
#pragma unroll
    for (int j = 0; j < 4; ++j) s += (v[j][0] + v[j][1]) + (v[j][2] + v[j][3]);
    float mean = wave_sum(s) * (1.f / 1024.f), q = 0.f;
#pragma unroll
    for (int j = 0; j < 4; ++j) { v[j] = v[j] - mean; q += (v[j][0] * v[j][0] + v[j][1] * v[j][1]) + (v[j][2] * v[j][2] + v[j][3] * v[j][3]); }
    float rstd = rsqrtf(wave_sum(q) * (1.f / 1024.f) + 1e-5f);
    if (AFF) {
#pragma unroll
        for (int j = 0; j < 4; ++j) { v[j] = v[j] * rstd * g[j] + bb[j]; *(f32x4*)(xout_row + 4 * lane + 256 * j) = v[j]; }
        if (!MOD) return;
        s = 0.f;
#pragma unroll
        for (int j = 0; j < 4; ++j) s += (v[j][0] + v[j][1]) + (v[j][2] + v[j][3]);
        mean = wave_sum(s) * (1.f / 1024.f); q = 0.f;
#pragma unroll
        for (int j = 0; j < 4; ++j) { v[j] = v[j] - mean; q += (v[j][0] * v[j][0] + v[j][1] * v[j][1]) + (v[j][2] * v[j][2] + v[j][3] * v[j][3]); }
        rstd = rsqrtf(wave_sum(q) * (1.f / 1024.f) + 1e-5f);
    }
    if (MOD) {
#pragma unroll
        for (int j = 0; j < 4; ++j) {
            const f32x4 o = v[j] * rstd * (sc[j] + 1.f) + sh[j];
            if (h_row) st_bf4(h_row + 4 * lane + 256 * j, o);
            if (h8_row) *(unsigned*)(h8_row + 4 * lane + 256 * j) = pk4_fp8(o[0] * H8_SCALE, o[1] * H8_SCALE, o[2] * H8_SCALE, o[3] * H8_SCALE);
        }
    }
}

DEV void ssm_pre_item(int l, int gi, LAS char* lds);
DEV void phase0(LAS char* lds) {
    const KA p = get_ka();
    const int tid = tidx(), nb = gridDim.x, bid = blockIdx.x;
    for (int it = nb - 1 - bid; it < 128; it += nb) ssm_pre_item(0, it, lds);
    {
        const int* pos = (const int*)p.in(2); float2* cs = (float2*)(p.ws() + OFF_CS);
        for (int idx = bid * 256 + tid; idx < T_ * 16; idx += nb * 256) {
            const int t = idx >> 4, i = idx & 15;
            const float invf = powf(10000.f, -(float)(2 * i) / 32.f);
            const float ang = (float)pos[t] * invf;
            float sn, cn; sincosf(ang, &sn, &cn);
            cs[idx] = make_float2(cn, sn);
        }
    }
    {
        const float* rw = (const float*)p.in(27); bf16_t* wr = (bf16_t*)(p.ws() + OFF_WR);
        for (int idx = bid * 256 + tid; idx < 128 * 2048; idx += nb * 256) {
            const int e = idx >> 11, k = idx & 2047; bf16_t o = 0;
            if (e < 64 && k < 1024) { const float w = rw[k * 32 + (e & 31)]; const bf16_t hi = f2bf(w); o = (e < 32) ? hi : f2bf(w - bf2f(hi)); }
            wr[idx] = o;
        }
    }
    for (int it = bid; it < NCVT_EARLY; it += nb) cvt_early_item(it, lds);
}

DEV void phase_lnmod0() {
    const KA p = get_ka();
    const int lane = tidx() & 63, gw = blockIdx.x * 4 + (tidx() >> 6), ngw = gridDim.x * 4;
    const float* x = (const float*)p.in(0); const float* ada = (const float*)(p.ws() + OFF_ADA);
    bf16_t* H = (bf16_t*)(p.ws() + OFF_H);
    const int rpw = T_ / ngw;
    if (rpw * ngw != T_ || (4096 % rpw) != 0) return;
    const int r0 = gw * rpw, b = r0 >> 12;
    f32x4 sc[4], sh[4], dum[4];
    ld_vec16(ada + b * 6144 + 0, lane, sh); ld_vec16(ada + b * 6144 + 1024, lane, sc);
#pragma unroll
    for (int j = 0; j < 4; ++j) dum[j] = (f32x4){0.f, 0.f, 0.f, 0.f};
    f32x4 v[4], vn[4];
#pragma unroll
    for (int j = 0; j < 4; ++j) v[j] = *(const f32x4*)(x + (size_t)r0 * 1024 + 4 * lane + 256 * j);
    for (int k = 0; k < rpw; ++k) {
        const int row = r0 + k;
        if (k + 1 < rpw) {
#pragma unroll
            for (int j = 0; j < 4; ++j) vn[j] = *(const f32x4*)(x + (size_t)(row + 1) * 1024 + 4 * lane + 256 * j);
        }
        ln_row<false, true>(v, lane, dum, dum, nullptr, sc, sh, nullptr, (unsigned char*)(p.ws() + OFF_H8) + (size_t)row * 1024);
#pragma unroll
        for (int j = 0; j < 4; ++j) v[j] = vn[j];
    }
}

DEV void pa_tile(int l, int it, int nxt, LAS char* lds, int& buf, bool primed) {
    const KA p = get_ka();
    const char* wl = p.ws() + OFF_W + (size_t)l * W_LAYER;
    const int mt = it / 20, nt = it - mt * 20;
    f32x4 acc[4][4]; zero_acc<4>(acc);
    {
        const RowsF<4> af = mk_rows<4>(p.ws() + OFF_H8, 1024, mt * 128);
        const RowsF<4> bf = mk_rows<4>(wl + W_IN, 1024, nt * 128);
        NextRows nx; nx.valid = nxt >= 0; nx.lds = lds; nx.abase = p.ws() + OFF_H8; nx.bbase = wl + W_IN; nx.apitch = 1024; nx.bpitch = 1024;
        { const int i2 = nxt >= 0 ? nxt : it, m2 = i2 / 20; nx.arow0 = m2 * 128; nx.brow0 = (i2 - m2 * 20) * 128; }
        gemm_core_f8<128>(acc, 8, af, bf, lds, buf, primed, nx);
    }
    EPI_VARS(128)
    bf16_t* dst; int pitch, ncol = 128;
    if (nt < 12) { dst = (bf16_t*)(p.ws() + OFF_XC + (size_t)(nt >> 2) * 32 * MiB) + (nt & 3) * 128; pitch = 512; }
    else if (nt < 16) { dst = (bf16_t*)(p.ws() + OFF_USSM) + (nt - 12) * 128; pitch = 512; }
    else if (nt < 18) { dst = (bf16_t*)(p.ws() + OFF_CQ) + (nt - 16) * 128; pitch = 256; }
    else if (nt < 19) { dst = (bf16_t*)(p.ws() + OFF_CKV); pitch = 128; }
    else { dst = (bf16_t*)(p.ws() + OFF_KR); pitch = 32; ncol = 32; }
    float* ssqp = (float*)(p.ws() + OFF_SSQP);
#pragma unroll
    for (int m = 0; m < 4; ++m) {
        const int row = mt * 128 + EPI_ROW(128, m);
        float sq = 0.f;
#pragma unroll
        for (int n = 0; n < 4; ++n) {
            const int col = EPI_COL(n);
            const f32x4 v = acc[m][n] * (1.f / (H8_SCALE * WI8_SCALE));
            if (nt >= 12 && nt < 16) st_bf4((bf16_t*)(p.ws() + OFF_USSM) + ((size_t)((nt - 12) * 8 + _wc * 4 + n) * T_ + row) * 16 + 4 * _fq, v);
            else if (col < ncol) st_bf4(dst + (size_t)row * pitch + col, v);
            sq += (v[0] * v[0] + v[1] * v[1]) + (v[2] * v[2] + v[3] * v[3]);
        }
        if (nt >= 16 && nt < 19) {
            sq += shx(sq, 16); sq += shx(sq, 32);
            if (_fq == 0) ssqp[(size_t)row * 8 + (nt - 16) * 2 + _wc] = sq;
        }
    }
}

DEV void ssm_pre_item(int l, int gi, LAS char* lds) {
    const int g = gi >> 2, part = gi & 3;
    const KA p = get_ka();
    LAS float* pwr = (LAS float*)lds;
    LAS float* pwi = pwr + 33 * 64;
    LAS float* ffr = pwi + 33 * 64;
    LAS float* ffi = ffr + 64;
    LAS float* ktab = ffi + 64;
    const int tid = tidx(), lg = l * 32 + g;
    const float dt = expf(((const float*)p.in(14))[lg]);
    const float* a_re = (const float*)p.in(7) + lg * 64; const float* a_im = (const float*)p.in(8) + lg * 64;
    const float* b_re = (const float*)p.in(9) + (size_t)lg * 64 * 16; const float* b_im = (const float*)p.in(10) + (size_t)lg * 64 * 16;
    const float* c_re = (const float*)p.in(11) + (size_t)lg * 16 * 64; const float* c_im = (const float*)p.in(12) + (size_t)lg * 16 * 64;
    for (int i = tid; i < 33 * 64; i += 256) {
        const int e = i >> 6, n = i & 63;
        const float mag = expf(a_re[n] * dt * (float)e); float sn, cn; sincosf(a_im[n] * dt * (float)e, &sn, &cn);
        pwr[i] = mag * cn; pwi[i] = mag * sn;
    }
    if (tid < 64) {
        const int n = tid; const float ar = a_re[n], ai = a_im[n];
        const float mag = expf(ar * dt); float sn, cn; sincosf(ai * dt, &sn, &cn);
        const float lre = mag * cn, lim = mag * sn, den = ar * ar + ai * ai, nr = lre - 1.f, ni = lim;
        ffr[n] = (nr * ar + ni * ai) / den; ffi[n] = (ni * ar - nr * ai) / den;
    }
    __syncthreads();
    {
        const int pp = tid >> 4, q = tid & 15;
        float acc[32];
#pragma unroll
        for (int k = 0; k < 32; ++k) acc[k] = 0.f;
        for (int n = 0; n < 64; ++n) {
            const float cre = c_re[pp * 64 + n], cim = c_im[pp * 64 + n];
            const float br = b_re[n * 16 + q], bi = b_im[n * 16 + q];
            const float fr = ffr[n], fi = ffi[n];
            const float bbr = fr * br - fi * bi, bbi = fr * bi + fi * br;
            const float wre = cre * bbr - cim * bbi, wim = cre * bbi + cim * bbr;
#pragma unroll
            for (int k = 0; k < 32; ++k) acc[k] += wre * pwr[k * 64 + n] - wim * pwi[k * 64 + n];
        }
#pragma unroll
        for (int k = 0; k < 32; ++k) ktab[k * 256 + pp * 16 + q] = acc[k];
    }
    __syncthreads();
    bf16_t* BT = (bf16_t*)(p.ws() + OFF_SBT) + (size_t)g * 512 * 768;
    for (int c = part * 128 * 64 + tid; c < (part + 1) * 128 * 64; c += 256) {
        const int row = c >> 6, kc = c & 63, i = row >> 4, pp = row & 15, j = kc >> 1, q0 = (kc & 1) * 8;
        u32x4 o = (u32x4){0u, 0u, 0u, 0u};
        if (i >= j) { const LAS float* s = ktab + (i - j) * 256 + pp * 16 + q0; o.x = pk2(s[0], s[1]); o.y = pk2(s[2], s[3]); o.z = pk2(s[4], s[5]); o.w = pk2(s[6], s[7]); }
        *(u32x4*)(BT + (size_t)row * 768 + kc * 8) = o;
    }
    for (int c = part * 128 * 16 + tid; c < (part + 1) * 128 * 16; c += 256) {
        const int row = c >> 4, kc2 = c & 15, i = row >> 4, pp = row & 15, n0 = (kc2 & 7) * 8, reim2 = kc2 >> 3;
        float v[8];
#pragma unroll
        for (int e = 0; e < 8; ++e) {
            const int n = n0 + e; const float cre = c_re[pp * 64 + n], cim = c_im[pp * 64 + n], lr = pwr[(i + 1) * 64 + n], li = pwi[(i + 1) * 64 + n];
            v[e] = reim2 == 0 ? (cre * lr - cim * li) : -(cre * li + cim * lr);
        }
        u32x4 o; o.x = pk2(v[0], v[1]); o.y = pk2(v[2], v[3]); o.z = pk2(v[4], v[5]); o.w = pk2(v[6], v[7]);
        *(u32x4*)(BT + (size_t)row * 768 + 512 + kc2 * 8) = o;
        *(u32x4*)(BT + (size_t)row * 768 + 640 + kc2 * 8) = o;
    }
    bf16_t* SG = (bf16_t*)(p.ws() + OFF_SG) + (size_t)g * 128 * 512;
    for (int c = part * 32 * 64 + tid; c < (part + 1) * 32 * 64; c += 256) {
        const int row = c >> 6, kc = c & 63, n = row & 63, reim = row >> 6, j = kc >> 1, q0 = (kc & 1) * 8;
        const float lr = pwr[(31 - j) * 64 + n], li = pwi[(31 - j) * 64 + n], fr = ffr[n], fi = ffi[n];
        float v[8];
#pragma unroll
        for (int e = 0; e < 8; ++e) {
            const float br = b_re[n * 16 + q0 + e], bi = b_im[n * 16 + q0 + e];
            const float bbr = fr * br - fi * bi, bbi = fr * bi + fi * br;
            v[e] = reim == 0 ? (lr * bbr - li * bbi) : (lr * bbi + li * bbr);
        }
        u32x4 o; o.x = pk2(v[0], v[1]); o.y = pk2(v[2], v[3]); o.z = pk2(v[4], v[5]); o.w = pk2(v[6], v[7]);
        *(u32x4*)(SG + (size_t)row * 512 + kc * 8) = o;
    }
    if (tid < 64 && part == 0) ((float2*)(p.ws() + OFF_LAML))[g * 64 + tid] = make_float2(pwr[32 * 64 + tid], pwi[32 * 64 + tid]);
    __syncthreads();
}

DEV void phase_a(int l, LAS char* lds) {
    const int nb = gridDim.x, bid = blockIdx.x;
    int buf = 0; bool primed = false;
#pragma unroll 1
    for (int it = vblock(); it < 256 * 20; it += nb) { const int nxt = it + nb < 256 * 20 ? it + nb : -1; pa_tile(l, it, nxt, lds, buf, primed); primed = nxt >= 0; }
}

DEV void rows_rinv(const bf16_t* base, int ncols, int row0, LAS char* lds) {
    LAS float* tbl = (LAS float*)(lds + LDS_WORK + 256);
    const int tid = tidx(), row = tid >> 1, half = tid & 1, n = ncols >> 1;
    const bf16_t* src = base + (size_t)(row0 + row) * ncols + half * n;
    float s = 0.f;
    for (int c = 0; c < n; c += 8) {
        const u32x4 w = *(const u32x4*)(src + c);
        const float a0 = bflo(w.x), a1 = bfhi(w.x), a2 = bflo(w.y), a3 = bfhi(w.y), a4 = bflo(w.z), a5 = bfhi(w.z), a6 = bflo(w.w), a7 = bfhi(w.w);
        s += (a0 * a0 + a1 * a1) + (a2 * a2 + a3 * a3) + (a4 * a4 + a5 * a5) + (a6 * a6 + a7 * a7);
    }
    s += shx(s, 1);
    __syncthreads();
    if (!half) tbl[row] = rsqrtf(s / (float)ncols + 1e-6f);
    __syncthreads();
}
DEV void pb_q_tile(int l, int it, int nxt, LAS char* lds, int& buf, bool primed) {
    const KA p = get_ka();
    const char* wl = p.ws() + OFF_W + (size_t)l * W_LAYER;
    const int mt = it >> 3, h = it & 7;
    float rq[4];
    { EPI_VARS(128) const float* ssqp = (const float*)(p.ws() + OFF_SSQP);
#pragma unroll
      for (int m = 0; m < 4; ++m) { const f32x4 s4 = *(const f32x4*)(ssqp + (size_t)(mt * 128 + EPI_ROW(128, m)) * 8); rq[m] = (s4[0] + s4[1]) + (s4[2] + s4[3]); } }
    f32x4 acc[4][4]; zero_acc<4>(acc);
    const RowsF<4> af = mk_rows<4>(p.ws() + OFF_CQ, 512, mt * 128);
    const RowsF<4> bf = mk_rows<4>(wl + W_UQ, 512, h * 128);
    NextT<RowsF<4>, RowsF<4> > nx; nx.valid = nxt >= 0; nx.lds = lds;
    { const int i2 = nxt >= 0 ? nxt : it; nx.a = mk_rows<4>(p.ws() + OFF_CQ, 512, (i2 >> 3) * 128); nx.b = mk_rows<4>(wl + W_UQ, 512, (i2 & 7) * 128); }
    gemm_core<128>(acc, 4, af, bf, lds, buf, primed, nx);
    EPI_VARS(128)
    const float2* cs = (const float2*)(p.ws() + OFF_CS); bf16_t* Q = (bf16_t*)(p.ws() + OFF_Q);
#pragma unroll
    for (int m = 0; m < 4; ++m) {
        const int rloc = EPI_ROW(128, m), row = mt * 128 + rloc, b = row >> 12, s = row & 4095;
        const float rinv = rsqrtf(rq[m] * (1.f / 256.f) + 1e-6f) * QSCALE_;
#pragma unroll
        for (int n = 0; n < 4; ++n) {
            const int d = EPI_COL(n);
            if (d < 96) {
                f32x4 v = acc[m][n] * rinv;
                if (d >= 64) {
                    const int i = (d - 64) >> 1; const float2 c0 = cs[row * 16 + i], c1 = cs[row * 16 + i + 1];
                    v = (f32x4){v[0] * c0.x - v[1] * c0.y, v[0] * c0.y + v[1] * c0.x, v[2] * c1.x - v[3] * c1.y, v[2] * c1.y + v[3] * c1.x};
                }
                st_bf4(Q + ((size_t)(b * 8 + h) * 4096 + s) * 96 + d, v);
            }
        }
    }
}
DEV void pb_k_tile(int l, int it, int nxt, LAS char* lds, int& buf, bool primed) {
    const KA p = get_ka();
    const char* wl = p.ws() + OFF_W + (size_t)l * W_LAYER;
    const int mt = it >> 2, nt = it & 3;
    float rk[4];
    { EPI_VARS(128) const float* ssqp = (const float*)(p.ws() + OFF_SSQP);
#pragma unroll
      for (int m = 0; m < 4; ++m) { const float2 s2 = *(const float2*)(ssqp + (size_t)(mt * 128 + EPI_ROW(128, m)) * 8 + 4); rk[m] = s2.x + s2.y; } }
    f32x4 acc[4][4]; zero_acc<4>(acc);
    const RowsF<4> af = mk_rows<4>(p.ws() + OFF_CKV, 256, mt * 128);
    const RowsF<4> bf = mk_rows<4>(wl + W_UK, 256, nt * 128);
    NextT<RowsF<4>, RowsF<4> > nx; nx.valid = nxt >= 0; nx.lds = lds;
    { const int i2 = nxt >= 0 ? nxt : it; nx.a = mk_rows<4>(p.ws() + OFF_CKV, 256, (i2 >> 2) * 128); nx.b = mk_rows<4>(wl + W_UK, 256, (i2 & 3) * 128); }
    gemm_core<128>(acc, 2, af, bf, lds, buf, primed, nx);
    EPI_VARS(128)
    bf16_t* KN = (bf16_t*)(p.ws() + OFF_KN);
#pragma unroll
    for (int m = 0; m < 4; ++m) {
        const int rloc = EPI_ROW(128, m), row = mt * 128 + rloc, b = row >> 12, s = row & 4095;
        const float rinv = rsqrtf(rk[m] * (1.f / 128.f) + 1e-6f);
#pragma unroll
        for (int n = 0; n < 4; ++n) {
            const int col = nt * 128 + EPI_COL(n), h = col >> 6, d = col & 63;
            st_bf4(KN + ((size_t)(b * 8 + h) * 4096 + s) * 64 + d, acc[m][n] * rinv);
        }
    }
}
DEV void pb_v_tile(int l, int it, int nxt, LAS char* lds, int& buf, bool primed) {
    const KA p = get_ka();
    const char* wl = p.ws() + OFF_W + (size_t)l * W_LAYER;
    const int mt = it & 3, nt = it >> 2;
    f32x4 rv[4];
    { EPI_VARS(128) const float* ssqp = (const float*)(p.ws() + OFF_SSQP);
#pragma unroll
      for (int n = 0; n < 4; ++n)
#pragma unroll
        for (int j = 0; j < 4; ++j) { const float2 s2 = *(const float2*)(ssqp + (size_t)(nt * 128 + EPI_COL(n) + j) * 8 + 4); rv[n][j] = s2.x + s2.y; } }
    f32x4 acc[4][4]; zero_acc<4>(acc);
    const RowsF<4> af = mk_rows<4>(wl + W_UV, 256, mt * 128);
    const RowsF<4> bf = mk_rows<4>(p.ws() + OFF_CKV, 256, nt * 128);
    NextT<RowsF<4>, RowsF<4> > nx; nx.valid = nxt >= 0; nx.lds = lds;
    { const int i2 = nxt >= 0 ? nxt : it; nx.a = mk_rows<4>(wl + W_UV, 256, (i2 & 3) * 128); nx.b = mk_rows<4>(p.ws() + OFF_CKV, 256, (i2 >> 2) * 128); }
    gemm_core<128>(acc, 2, af, bf, lds, buf, primed, nx);
    EPI_VARS(128)
    bf16_t* VT = (bf16_t*)(p.ws() + OFF_VT);
#pragma unroll
    for (int n = 0; n < 4; ++n) {
        const int cloc = EPI_COL(n), tok = nt * 128 + cloc, b = tok >> 12, s = tok & 4095;
        const f32x4 rinv = (f32x4){rsqrtf(rv[n][0] * (1.f / 128.f) + 1e-6f), rsqrtf(rv[n][1] * (1.f / 128.f) + 1e-6f), rsqrtf(rv[n][2] * (1.f / 128.f) + 1e-6f), rsqrtf(rv[n][3] * (1.f / 128.f) + 1e-6f)};
#pragma unroll
        for (int m = 0; m < 4; ++m) {
            const int r = mt * 128 + EPI_ROW(128, m), h = r >> 6, dv = r & 63;
            st_bf4(VT + ((size_t)(b * 8 + h) * 64 + dv) * 4096 + s, acc[m][n] * rinv);
        }
    }
}
DEV void pb_elem_item(int l, int it) {
    const KA p = get_ka();
    const int tid = tidx(), t0 = it * 64;
    const bf16_t* xc = (const bf16_t*)(p.ws() + OFF_XC); const bf16_t* gc = (const bf16_t*)(p.ws() + OFF_GC); bf16_t* gbp = (bf16_t*)(p.ws() + OFF_GB);
    const float* cw = (const float*)p.in(6) + l * 3 * 512;
    {
        const int ch = (tid & 63) * 8;
        float w0[8], w1[8], w2[8];
#pragma unroll
        for (int e = 0; e < 8; ++e) { w0[e] = cw[ch + e]; w1[e] = cw[512 + ch + e]; w2[e] = cw[1024 + ch + e]; }
        for (int tt = tid >> 6; tt < 64; tt += 4) {
            const int t = t0 + tt, s = t & 4095;
            const size_t o = (size_t)t * 512 + ch;
            float u0[8], u1[8], u2[8], gbv[8];
            {
                const u32x4 a = *(const u32x4*)(xc + o), g = *(const u32x4*)(gc + o), gb = *(const u32x4*)(gbp + o);
                const unsigned aw[4] = {a.x, a.y, a.z, a.w}, gw[4] = {g.x, g.y, g.z, g.w}, bw[4] = {gb.x, gb.y, gb.z, gb.w};
#pragma unroll
                for (int e = 0; e < 4; ++e) { u2[2 * e] = bflo(aw[e]) * bflo(gw[e]); u2[2 * e + 1] = bfhi(aw[e]) * bfhi(gw[e]); gbv[2 * e] = bflo(bw[e]); gbv[2 * e + 1] = bfhi(bw[e]); }
            }
            if (s >= 1) {
                const u32x4 a = *(const u32x4*)(xc + o - 512), g = *(const u32x4*)(gc + o - 512);
                const unsigned aw[4] = {a.x, a.y, a.z, a.w}, gw[4] = {g.x, g.y, g.z, g.w};
#pragma unroll
                for (int e = 0; e < 4; ++e) { u1[2 * e] = bflo(aw[e]) * bflo(gw[e]); u1[2 * e + 1] = bfhi(aw[e]) * bfhi(gw[e]); }
            } else {
#pragma unroll
                for (int e = 0; e < 8; ++e) u1[e] = 0.f;
            }
            if (s >= 2) {
                const u32x4 a = *(const u32x4*)(xc + o - 1024), g = *(const u32x4*)(gc + o - 1024);
                const unsigned aw[4] = {a.x, a.y, a.z, a.w}, gw[4] = {g.x, g.y, g.z, g.w};
#pragma unroll
                for (int e = 0; e < 4; ++e) { u0[2 * e] = bflo(aw[e]) * bflo(gw[e]); u0[2 * e + 1] = bfhi(aw[e]) * bfhi(gw[e]); }
            } else {
#pragma unroll
                for (int e = 0; e < 8; ++e) u0[e] = 0.f;
            }
            float ov[8];
#pragma unroll
            for (int e = 0; e < 8; ++e) ov[e] = gbv[e] * (w0[e] * u0[e] + w1[e] * u1[e] + w2[e] * u2[e]);
            u32x2 o2; o2.x = pk4_fp8(clamp8(ov[0] * 2.f), clamp8(ov[1] * 2.f), clamp8(ov[2] * 2.f), clamp8(ov[3] * 2.f)); o2.y = pk4_fp8(clamp8(ov[4] * 2.f), clamp8(ov[5] * 2.f), clamp8(ov[6] * 2.f), clamp8(ov[7] * 2.f));
            *(u32x2*)((unsigned char*)(p.ws() + OFF_H) + o) = o2;
        }
    }
    {
        const bf16_t* kr = (const bf16_t*)(p.ws() + OFF_KR); const float2* cs = (const float2*)(p.ws() + OFF_CS); bf16_t* KRP = (bf16_t*)(p.ws() + OFF_KRP);
        for (int idx = tid; idx < 64 * 16; idx += 256) {
            const int t = t0 + (idx >> 4), i = idx & 15;
            const float x1 = bf2f(kr[t * 32 + i]), x2 = bf2f(kr[t * 32 + 16 + i]); const float2 c = cs[t * 16 + i];
            *(unsigned*)(KRP + (size_t)t * 32 + 2 * i) = pk2(x1 * c.x - x2 * c.y, x1 * c.y + x2 * c.x);
        }
    }
}
DEV void phase_b(int l, LAS char* lds) {
    const int nb = gridDim.x, bid = blockIdx.x;
    for (int it = bid; it < 512; it += nb) pb_elem_item(l, it);
    const int vb = vblock();
    { int buf = 0; bool primed = false;
      for (int it = vb; it < 2048; it += nb) { const int nxt = it + nb < 2048 ? it + nb : -1; pb_q_tile(l, it, nxt, lds, buf, primed); primed = nxt >= 0; } }
    { int buf = 0; bool primed = false;
      for (int it = vb; it < 1024; it += nb) { const int nxt = it + nb < 1024 ? it + nb : -1; pb_k_tile(l, it, nxt, lds, buf, primed); primed = nxt >= 0; } }
    { int buf = 0; bool primed = false;
      for (int it = vb; it < 1024; it += nb) { const int nxt = it + nb < 1024 ? it + nb : -1; pb_v_tile(l, it, nxt, lds, buf, primed); primed = nxt >= 0; } }
}

DEV void attn_item(int b, int h, int qb, LAS char* lds) {
    const KA p = get_ka();
    constexpr int KN = 0, KR = 8192, VV = 12288, ST = 20480;
    const int tid = tidx(), lane = tid & 63, wid = tid >> 6, r = lane & 31, hh = lane >> 5;
    const int bh = b * 8 + h, q0 = qb * 128 + wid * 32;
    const bf16_t* Qp = (const bf16_t*)(p.ws() + OFF_Q) + ((size_t)bh * 4096 + q0 + r) * 96;
    bf16x8 qf[6];
#pragma unroll
    for (int s = 0; s < 6; ++s) qf[s] = *(const bf16x8*)(Qp + 16 * s + 8 * hh);
    const char* Kg = p.ws() + OFF_KN + (size_t)bh * 4096 * 128;
    const char* Rg = p.ws() + OFF_KRP + (size_t)b * 4096 * 64;
    const char* Vg = p.ws() + OFF_VT + (size_t)bh * 64 * 8192;
    const char* kn_src[2]; const char* v_src[2]; const char* kr_src;
#pragma unroll
    for (int i = 0; i < 2; ++i) {
        const int pp = tid + 256 * i, row = pp >> 3, s = pp & 7, q = s ^ ((row >> 1) & 7);
        const int key = (row & ~12) | ((row & 4) << 1) | ((row & 8) >> 1);
        kn_src[i] = Kg + (size_t)key * 128 + q * 16;
        v_src[i] = Vg + (size_t)row * 8192 + q * 16;
    }
    {
        const int row = tid >> 2, s = tid & 3, g = (row >> 2) & 3, f = (0x78 >> (2 * g)) & 3, q = s ^ f;
        const int key = (row & ~12) | ((row & 4) << 1) | ((row & 8) >> 1);
        kr_src = Rg + (size_t)key * 64 + q * 16;
    }
    const int wbase = wid * 1024;
#define AT_STAGE(t, buf) do { LAS char* _s = lds + (buf) * ST + wbase; \
        __builtin_amdgcn_global_load_lds((const GAS unsigned*)(kn_src[0] + (size_t)(t) * (64 * 128)), (LAS unsigned*)(_s + KN), 16, 0, 0); \
        __builtin_amdgcn_global_load_lds((const GAS unsigned*)(kn_src[1] + (size_t)(t) * (64 * 128)), (LAS unsigned*)(_s + KN + 4096), 16, 0, 0); \
        __builtin_amdgcn_global_load_lds((const GAS unsigned*)(kr_src + (size_t)(t) * (64 * 64)), (LAS unsigned*)(_s + KR), 16, 0, 0); \
        __builtin_amdgcn_global_load_lds((const GAS unsigned*)(v_src[0] + (size_t)(t) * 128), (LAS unsigned*)(_s + VV), 16, 0, 0); \
        __builtin_amdgcn_global_load_lds((const GAS unsigned*)(v_src[1] + (size_t)(t) * 128), (LAS unsigned*)(_s + VV + 4096), 16, 0, 0); } while (0)
    f32x16 o0, o1;
#pragma unroll
    for (int i = 0; i < 16; ++i) { o0[i] = 0.f; o1[i] = 0.f; }
    float mrun = -INFINITY, lrun = 0.f;
    const int ntiles = 2 * qb + 2;
    const int swn = (r >> 1) & 7;
    const int fro = (0x78 >> (2 * ((r >> 2) & 3))) & 3;
    AT_STAGE(0, 0);
    AT_STAGE(1, 1);
    asm volatile("s_waitcnt vmcnt(5)" ::: "memory");
    __builtin_amdgcn_s_barrier();
    int buf = 0;
    for (int t = 0; t < ntiles; ++t) {
        const bool more = t + 2 < ntiles;
        if (more) { const int b2 = buf == 0 ? 2 : buf - 1; AT_STAGE(t + 2, b2); }
        const int key0 = t * 64;
        if (key0 <= q0 + 31) {
            const LAS char* base = lds + buf * ST;
            f32x16 st[2];
            bf16x8 kfr[2][6];
#pragma unroll
            for (int kb = 0; kb < 2; ++kb) {
                const LAS char* kn = base + KN + (kb * 32 + r) * 128;
                const LAS char* kr = base + KR + (kb * 32 + r) * 64;
#pragma unroll
                for (int s = 0; s < 4; ++s) kfr[kb][s] = *(const LAS bf16x8*)(kn + (((2 * s + hh) ^ swn) * 16));
#pragma unroll
                for (int s = 0; s < 2; ++s) kfr[kb][4 + s] = *(const LAS bf16x8*)(kr + (((2 * s + hh) ^ fro) * 16));
            }
            __builtin_amdgcn_sched_barrier(0);
#pragma unroll
            for (int kb = 0; kb < 2; ++kb)
#pragma unroll
                for (int i = 0; i < 16; ++i) st[kb][i] = 0.f;
#pragma unroll
            for (int s = 0; s < 6; ++s)
#pragma unroll
                for (int kb = 0; kb < 2; ++kb) st[kb] = __builtin_amdgcn_mfma_f32_32x32x16_bf16(kfr[kb][s], qf[s], st[kb], 0, 0, 0);
            bf16x8 vfr[2][2][2];
            {
                const LAS char* v0 = base + VV + r * 128;
                const LAS char* v1 = base + VV + (32 + r) * 128;
#pragma unroll
                for (int kb = 0; kb < 2; ++kb)
#pragma unroll
                    for (int s2 = 0; s2 < 2; ++s2) {
                        const int c = (4 * kb + 2 * s2 + hh) ^ swn;
                        vfr[kb][s2][0] = *(const LAS bf16x8*)(v0 + c * 16);
                        vfr[kb][s2][1] = *(const LAS bf16x8*)(v1 + c * 16);
                    }
            }
            __builtin_amdgcn_sched_barrier(0);
            if (key0 + 63 > q0) {
                const int qi = q0 + r;
#pragma unroll
                for (int kb = 0; kb < 2; ++kb)
#pragma unroll
                    for (int i = 0; i < 16; ++i) {
                        const int key = key0 + kb * 32 + (i & 3) + 4 * ((i >> 2) & 1) + 8 * hh + 16 * (i >> 3);
                        if (key > qi) st[kb][i] = -INFINITY;
                    }
            }
            float tm = st[0][0];
#pragma unroll
            for (int i = 1; i < 16; ++i) tm = fmaxf(tm, st[0][i]);
#pragma unroll
            for (int i = 0; i < 16; ++i) tm = fmaxf(tm, st[1][i]);
            tm = fmaxf(tm, shx(tm, 32));
            if (__builtin_amdgcn_ballot_w64(tm > mrun + 8.f) != 0ull) {
                const float mnew = fmaxf(mrun, tm);
                const float alpha = __builtin_amdgcn_exp2f(mrun - mnew);
                mrun = mnew;
                lrun *= alpha;
#pragma unroll
                for (int i = 0; i < 16; ++i) { o0[i] *= alpha; o1[i] *= alpha; }
            }
            float ps = 0.f;
#pragma unroll
            for (int kb = 0; kb < 2; ++kb)
#pragma unroll
                for (int i = 0; i < 16; ++i) { const float e = __builtin_amdgcn_exp2f(st[kb][i] - mrun); st[kb][i] = e; ps += e; }
            lrun += ps;
#pragma unroll
            for (int kb = 0; kb < 2; ++kb)
#pragma unroll
                for (int s2 = 0; s2 < 2; ++s2) {
                    union { u32x4 u; bf16x8 v; } pb;
                    pb.u.x = pk2(st[kb][8 * s2 + 0], st[kb][8 * s2 + 1]); pb.u.y = pk2(st[kb][8 * s2 + 2], st[kb][8 * s2 + 3]);
                    pb.u.z = pk2(st[kb][8 * s2 + 4], st[kb][8 * s2 + 5]); pb.u.w = pk2(st[kb][8 * s2 + 6], st[kb][8 * s2 + 7]);
                    o0 = __builtin_amdgcn_mfma_f32_32x32x16_bf16(vfr[kb][s2][0], pb.v, o0, 0, 0, 0);
                    o1 = __builtin_amdgcn_mfma_f32_32x32x16_bf16(vfr[kb][s2][1], pb.v, o1, 0, 0, 0);
                }
        }
        if (more) asm volatile("s_waitcnt vmcnt(5)" ::: "memory"); else asm volatile("s_waitcnt vmcnt(0)" ::: "memory");
        __builtin_amdgcn_s_barrier();
        buf = buf == 2 ? 0 : buf + 1;
    }
#undef AT_STAGE
    const float ltot = lrun + shx(lrun, 32);
    const float inv = 1.f / ltot;
    unsigned char* O = (unsigned char*)(p.ws() + OFF_XC) + (size_t)(b * 4096 + q0 + r) * 512 + h * 64;
    const float inv8 = inv * 16.f;
#pragma unroll
    for (int g4 = 0; g4 < 4; ++g4) {
        const int dv = 8 * g4 + 4 * hh;
        *(unsigned*)(O + dv) = pk4_fp8(clamp8(o0[4 * g4] * inv8), clamp8(o0[4 * g4 + 1] * inv8), clamp8(o0[4 * g4 + 2] * inv8), clamp8(o0[4 * g4 + 3] * inv8));
        *(unsigned*)(O + 32 + dv) = pk4_fp8(clamp8(o1[4 * g4] * inv8), clamp8(o1[4 * g4 + 1] * inv8), clamp8(o1[4 * g4 + 2] * inv8), clamp8(o1[4 * g4 + 3] * inv8));
    }
}

struct SsmAF { const char* ub; const char* sb; unsigned pu[4]; unsigned ps[4]; int n1;
    DEV const char* operator()(int step, int i) const { return step < n1 ? ub + (pu[i] + (unsigned)step * 128u) : sb + (ps[i] + (unsigned)(step - n1) * 128u); } };
struct SsmBF { const char* bb; unsigned pb[4]; int n1;
    DEV const char* operator()(int step, int i) const { return bb + (pb[i] + (step < n1 ? (unsigned)step * 128u : 1024u + (unsigned)(step - n1) * 128u)); } };
DEV void ssm_item(int l, int g, int b, LAS char* lds) {
    const KA p = get_ka();
    const int tid = tidx();
    const int sr = stage_row(tid), sq = stage_q(tid);
    const char* U = p.ws() + OFF_USSM;
    float* E = (float*)(p.ws() + OFF_CQ) + (size_t)(g * 1024 + b * 128) * 128;
    bf16_t* SP = (bf16_t*)(p.ws() + OFF_SPREV) + (size_t)(g * 1024 + b * 128) * 256;
    SsmAF af; af.n1 = 8; af.ub = U + ((size_t)g * T_ + (size_t)b * 4096) * 32; af.sb = (const char*)SP;
#pragma unroll
    for (int i = 0; i < 4; ++i) {
        const int row = sr + 32 * i;
        af.pu[i] = (unsigned)(row * 1024 + sq * 16);
        af.ps[i] = (unsigned)(row * 256 + sq * 8) * 2u;
    }
    {
        f32x4 acc[4][4]; zero_acc<4>(acc);
        const RowsF<4> bf = mk_rows<4>(p.ws() + OFF_SG + (size_t)g * 128 * 512 * 2, 1024, 0);
        gemm_core<128>(acc, 8, af, bf, lds);
        EPI_VARS(128)
#pragma unroll
        for (int m = 0; m < 4; ++m)
#pragma unroll
            for (int n = 0; n < 4; ++n) *(f32x4*)(E + (size_t)EPI_ROW(128, m) * 128 + EPI_COL(n)) = acc[m][n];
    }
    __syncthreads();
    if (tid < 64) {
        const float2 lam = ((const float2*)(p.ws() + OFF_LAML))[g * 64 + tid];
        float sre = 0.f, sim = 0.f;
#pragma unroll 1
        for (int c0 = 0; c0 < 128; c0 += 16) {
            float er[16], ei[16];
#pragma unroll
            for (int k = 0; k < 16; ++k) { er[k] = E[(c0 + k) * 128 + tid]; ei[k] = E[(c0 + k) * 128 + 64 + tid]; }
#pragma unroll
            for (int k = 0; k < 16; ++k) {
                const int c = c0 + k;
                const bf16_t hr = f2bf(sre), hi = f2bf(sim);
                SP[c * 256 + tid] = hr; SP[c * 256 + 64 + tid] = hi;
                SP[c * 256 + 128 + tid] = f2bf(sre - bf2f(hr)); SP[c * 256 + 192 + tid] = f2bf(sim - bf2f(hi));
                const float nr = lam.x * sre - lam.y * sim + er[k], ni = lam.x * sim + lam.y * sre + ei[k];
                sre = nr; sim = ni;
            }
        }
    }
    __syncthreads();
    const float* dsk = (const float*)p.in(13) + l * 512 + g * 16;
    unsigned char* GY = (unsigned char*)(p.ws() + OFF_GC) + (size_t)g * T_ * 16;
    int cbuf = 0;
    for (int nt = 0; nt < 4; ++nt) {
        f32x4 acc[4][4]; zero_acc<4>(acc);
        af.n1 = 2 * (nt + 1);
        SsmBF bf; bf.n1 = af.n1; bf.bb = p.ws() + OFF_SBT + (size_t)(g * 512 + nt * 128) * 768 * 2;
#pragma unroll
        for (int i = 0; i < 4; ++i) bf.pb[i] = (unsigned)((sr + 32 * i) * 768 + sq * 8) * 2u;
        NextT<SsmAF, SsmBF> nx; nx.valid = nt < 3; nx.lds = lds; nx.a = af; nx.a.n1 = af.n1 + 2; nx.b = bf; nx.b.n1 = af.n1 + 2; nx.b.bb = bf.bb + (size_t)128 * 768 * 2;
        gemm_core<128>(acc, af.n1 + 4, af, bf, lds, cbuf, nt > 0, nx);
        EPI_VARS(128)
#pragma unroll
        for (int m = 0; m < 4; ++m) {
            const int c = EPI_ROW(128, m);
#pragma unroll
            for (int n = 0; n < 4; ++n) {
                const int col = nt * 128 + EPI_COL(n), i = col >> 4, pp = col & 15;
                const size_t tok = (size_t)b * 4096 + c * 32 + i;
                const f32x4 u = ld_bf4((const bf16_t*)U + ((size_t)g * T_ + tok) * 16 + pp);
                const f32x4 d = *(const f32x4*)(dsk + pp);
                const f32x4 y = acc[m][n] + d * u;
                *(unsigned*)(GY + tok * 16 + pp) = pk4_fp8(clamp8(gelu_tanh(y[0]) * GY8_SCALE), clamp8(gelu_tanh(y[1]) * GY8_SCALE), clamp8(gelu_tanh(y[2]) * GY8_SCALE), clamp8(gelu_tanh(y[3]) * GY8_SCALE));
            }
        }
    }
}
DEV void phase_c(int l, unsigned* qbase, LAS char* lds) {
    LAS int* slot = (LAS int*)(lds + LDS_WORK);
    const int x0 = (int)((unsigned)__builtin_amdgcn_s_getreg((3 << 11) | 20) & 7u);
#pragma unroll 1
    for (int k = 0; k < 8; ++k) {
        const int x = (x0 + k) & 7;
        unsigned* qctr = qbase + 64 * x;
        for (;;) {
            const int it = next_item(qctr, slot);
            if (it >= 32 + 256 * 2) break;
            if (it < 32) ssm_item(l, 4 * x + (it >> 3), it & 7, lds);
            else {
                const int j = it - 32, idx = j >> 1;
                if ((j & 1) == 0) { const int rem = idx & 63, qb = 31 - (rem >> 1), h = (idx >> 6) * 2 + (rem & 1); attn_item(x, h, qb, lds); }
                else { const int bq = x * 256 + idx, g3 = (bq >> 1) * 3; if ((bq & 1) == 0) { cvt_expert_item(l, g3, lds); cvt_expert_item(l, g3 + 1, lds); } else cvt_expert_item(l, g3 + 2, lds); }
            }
        }
    }
}

DEV void conv8_pass() {
    const KA p = get_ka();
    const bf16_t* gb = (const bf16_t*)(p.ws() + OFF_GB); unsigned char* c8 = (unsigned char*)(p.ws() + OFF_E);
    for (size_t i = (size_t)blockIdx.x * 256 + tidx(); i < (size_t)T_ * 512 / 16; i += (size_t)gridDim.x * 256) {
        const u32x4 a = *(const u32x4*)(gb + i * 16), b = *(const u32x4*)(gb + i * 16 + 8);
        u32x4 o;
        o.x = pk4_fp8(clamp8(bflo(a.x) * 2.f), clamp8(bfhi(a.x) * 2.f), clamp8(bflo(a.y) * 2.f), clamp8(bfhi(a.y) * 2.f));
        o.y = pk4_fp8(clamp8(bflo(a.z) * 2.f), clamp8(bfhi(a.z) * 2.f), clamp8(bflo(a.w) * 2.f), clamp8(bfhi(a.w) * 2.f));
        o.z = pk4_fp8(clamp8(bflo(b.x) * 2.f), clamp8(bfhi(b.x) * 2.f), clamp8(bflo(b.y) * 2.f), clamp8(bfhi(b.y) * 2.f));
        o.w = pk4_fp8(clamp8(bflo(b.z) * 2.f), clamp8(bfhi(b.z) * 2.f), clamp8(bflo(b.w) * 2.f), clamp8(bfhi(b.w) * 2.f));
        *(u32x4*)(c8 + i * 16) = o;
    }
}
struct GyAF { const char* base; unsigned off[4];
    DEV const char* operator()(int step, int i) const { return base + (off[i] + (unsigned)step * (unsigned)(8 * T_ * 16)); } };
struct NextGy {
    const char* abase; const void* bbase; int mt, brow0; bool valid; LAS char* lds;
    DEV bool operator()(int step, int buf) const {
        if (valid) {
            GyAF a; const int _t = tidx(); const int r = stage_row(_t), q = stage_q(_t); a.base = abase + (size_t)mt * 128 * 16;
#pragma unroll
            for (int i = 0; i < 4; ++i) a.off[i] = (unsigned)(r + 32 * i) * 16u + (unsigned)q * (unsigned)(T_ * 16);
            stage_tile<128>(a, mk_rows<4>(bbase, 512, brow0), step, lds, buf);
        }
        return valid;
    }
};
DEV void pd1_tile(int l, int it, int nxt, LAS char* lds, int& buf, bool primed) {
    const KA p = get_ka();
    const char* wl = p.ws() + OFF_W + (size_t)l * W_LAYER;
    const int mt = it >> 3, nt = it & 7;
    f32x4 acc[4][4]; zero_acc<4>(acc);
    GyAF af; { const int _t = tidx(); const int r = stage_row(_t), q = stage_q(_t); af.base = p.ws() + OFF_GC + (size_t)mt * 128 * 16;
#pragma unroll
        for (int i = 0; i < 4; ++i) af.off[i] = (unsigned)(r + 32 * i) * 16u + (unsigned)q * (unsigned)(T_ * 16); }
    const RowsF<4> bf = mk_rows<4>(wl + W_GLU, 512, nt * 128);
    NextGy nx; nx.valid = nxt >= 0; nx.lds = lds; nx.abase = p.ws() + OFF_GC; nx.bbase = wl + W_GLU;
    { const int i2 = nxt >= 0 ? nxt : it; nx.mt = i2 >> 3; nx.brow0 = (i2 & 7) * 128; }
    gemm_core_f8<128>(acc, 4, af, bf, lds, buf, primed, nx);
    EPI_VARS(128)
    unsigned char* GO = (unsigned char*)(p.ws() + OFF_USSM);
#pragma unroll
    for (int m = 0; m < 4; ++m) {
        const int row = mt * 128 + EPI_ROW(128, m);
#pragma unroll
        for (int n = 0; n < 2; ++n) {
            const f32x4 v = acc[m][n] * (8.f / (GY8_SCALE * WL8_SCALE)), gte = acc[m][n + 2] * (1.f / (GY8_SCALE * WL8_SCALE));
            const int col = nt * 64 + _wc * 32 + n * 16 + _fq * 4;
            *(unsigned*)(GO + (size_t)row * 512 + col) = pk4_fp8(clamp8(v[0] * sigmoidf_(gte[0])), clamp8(v[1] * sigmoidf_(gte[1])), clamp8(v[2] * sigmoidf_(gte[2])), clamp8(v[3] * sigmoidf_(gte[3])));
        }
    }
}
DEV void pd2_tile(int l, int it, int nxt, LAS char* lds, int& buf, bool primed) {
    const KA p = get_ka();
    const char* wl = p.ws() + OFF_W + (size_t)l * W_LAYER;
    const int mt = it >> 3, nt = it & 7;
    u32x2 mgp[4][4];
#pragma unroll
    for (int m = 0; m < 4; ++m)
#pragma unroll
        for (int n = 0; n < 4; ++n) mgp[m][n] = (u32x2){0u, 0u};
#pragma unroll 1
    for (int br = 0; br < 3; ++br) {
        u32x2 sp[4][4];
        const void* abase = br == 0 ? (const void*)(p.ws() + OFF_H) : br == 1 ? (const void*)(p.ws() + OFF_USSM) : (const void*)(p.ws() + OFF_XC);
        const void* bbase = wl + W_UPC + (size_t)br * 1024 * 512 * 2;
        const float ysc = 1.f / (WU8_SCALE * (br == 0 ? 2.f : br == 1 ? 8.f : 16.f));
        {
            f32x4 acc[4][4]; zero_acc<4>(acc);
            const RowsF<4> ah = mk_rows<4>(p.ws() + OFF_H8, 1024, mt * 128);
            const RowsF<4> bg = mk_rows<4>(wl + W_G, 1024, br * 1024 + nt * 128);
            NextRows nx; nx.valid = true; nx.lds = lds; nx.abase = abase; nx.apitch = 512; nx.arow0 = mt * 128; nx.bbase = bbase; nx.bpitch = 512; nx.brow0 = nt * 128;
            gemm_core_f8<128>(acc, 8, ah, bg, lds, buf, primed, nx);
#pragma unroll
            for (int m = 0; m < 4; ++m)
#pragma unroll
                for (int n = 0; n < 4; ++n) {
                    const f32x4 g = acc[m][n] * (1.f / (H8_SCALE * WG8_SCALE));
                    sp[m][n].x = pk2(sigmoidf_(g[0]), sigmoidf_(g[1])); sp[m][n].y = pk2(sigmoidf_(g[2]), sigmoidf_(g[3]));
                }
        }
        {
            f32x4 acc[4][4]; zero_acc<4>(acc);
            NextRows nx; nx.lds = lds;
            {
                const int b2 = br < 2 ? br + 1 : 0, i2 = br < 2 ? it : (nxt >= 0 ? nxt : it), m2 = i2 >> 3, n2 = i2 & 7;
                nx.valid = br < 2 || nxt >= 0;
                nx.abase = p.ws() + OFF_H8; nx.apitch = 1024; nx.arow0 = m2 * 128; nx.bbase = wl + W_G; nx.bpitch = 1024; nx.brow0 = b2 * 1024 + n2 * 128;
            }
            const RowsF<4> ay = mk_rows<4>(abase, 512, mt * 128);
            const RowsF<4> by = mk_rows<4>(bbase, 512, nt * 128);
            gemm_core_f8<128>(acc, 4, ay, by, lds, buf, true, nx);
#pragma unroll
            for (int m = 0; m < 4; ++m)
#pragma unroll
                for (int n = 0; n < 4; ++n) {
                    const f32x4 sg = (f32x4){bflo(sp[m][n].x), bfhi(sp[m][n].x), bflo(sp[m][n].y), bfhi(sp[m][n].y)};
                    const f32x4 mo = (f32x4){bflo(mgp[m][n].x), bfhi(mgp[m][n].x), bflo(mgp[m][n].y), bfhi(mgp[m][n].y)} + sg * acc[m][n] * ysc;
                    mgp[m][n].x = pk2(mo[0], mo[1]); mgp[m][n].y = pk2(mo[2], mo[3]);
                }
        }
        primed = true;
    }
    EPI_VARS(128)
    bf16_t* MG = (bf16_t*)(p.ws() + OFF_MERGED);
#pragma unroll
    for (int m = 0; m < 4; ++m)
#pragma unroll
        for (int n = 0; n < 4; ++n) {
            *(unsigned*)((unsigned char*)MG + (size_t)(mt * 128 + EPI_ROW(128, m)) * 1024 + nt * 128 + EPI_COL(n)) = pk4_fp8(clamp8(bflo(mgp[m][n].x) * MG8_SCALE), clamp8(bfhi(mgp[m][n].x) * MG8_SCALE), clamp8(bflo(mgp[m][n].y) * MG8_SCALE), clamp8(bfhi(mgp[m][n].y) * MG8_SCALE));
        }
}
DEV void pd3a_tile(int l, int it, int nxt, LAS char* lds, int& buf, bool primed) {
    const KA p = get_ka();
    const char* wl = p.ws() + OFF_W + (size_t)l * W_LAYER;
    const int mt = it >> 3, nt = it & 7;
    f32x4 acc[4][4]; zero_acc<4>(acc);
    const RowsF<4> af = mk_rows<4>(p.ws() + OFF_MERGED, 1024, mt * 128);
    const RowsF<4> bf = mk_rows<4>(wl + W_O, 1024, nt * 128);
    NextRows nx; nx.valid = nxt >= 0; nx.lds = lds;
    { const int i2 = nxt >= 0 ? nxt : it; nx.abase = p.ws() + OFF_MERGED; nx.apitch = 1024; nx.arow0 = (i2 >> 3) * 128; nx.bbase = wl + W_O; nx.bpitch = 1024; nx.brow0 = (i2 & 7) * 128; }
    gemm_core_f8<128>(acc, 8, af, bf, lds, buf, primed, nx);
    EPI_VARS(128)
    bf16_t* Y = (bf16_t*)(p.ws() + OFF_XC);
#pragma unroll
    for (int m = 0; m < 4; ++m)
#pragma unroll
        for (int n = 0; n < 4; ++n) st_bf4(Y + (size_t)(mt * 128 + EPI_ROW(128, m)) * 1024 + nt * 128 + EPI_COL(n), acc[m][n] * (1.f / (MG8_SCALE * WO8_SCALE)));
}
DEV void pd3b_item(int l, int st, LAS char* lds) {
    const KA p = get_ka();
    const int tid = tidx(), lane = tid & 63, wid = tid >> 6;
    const int row0 = st * 64, b = row0 >> 12;
    const float* ada = (const float*)(p.ws() + OFF_ADA) + ((size_t)l * 8 + b) * 6144;
    float* xout = p.out();
    {
        bf16_t* H = (bf16_t*)(p.ws() + OFF_H);
        f32x4 g[4], bb[4], sc[4], sh[4], g1[4];
        ld_vec16((const float*)p.in(25) + (l * 2 + 0) * 1024, lane, g); ld_vec16((const float*)p.in(26) + (l * 2 + 0) * 1024, lane, bb);
        ld_vec16(ada + 3072, lane, sh); ld_vec16(ada + 4096, lane, sc); ld_vec16(ada + 2048, lane, g1);
        const float* xin = l == 0 ? (const float*)p.in(0) : (const float*)p.out();
        const bf16_t* Y = (const bf16_t*)(p.ws() + OFF_XC);
        const int r0 = row0 + wid * 16;
        f32x4 xv[4]; u32x2 yv[4];
#define P3_LOAD(row) do { _Pragma("unroll") for (int j = 0; j < 4; ++j) { const int col = 4 * lane + 256 * j; \
            xv[j] = *(const f32x4*)(xin + (size_t)(row) * 1024 + col); yv[j] = *(const u32x2*)(Y + (size_t)(row) * 1024 + col); } } while (0)
        P3_LOAD(r0);
        for (int k = 0; k < 16; ++k) {
            const int row = r0 + k;
            f32x4 v[4];
#pragma unroll
            for (int j = 0; j < 4; ++j) v[j] = xv[j] * ALPHA_ + g1[j] * (f32x4){bflo(yv[j].x), bfhi(yv[j].x), bflo(yv[j].y), bfhi(yv[j].y)};
            if (k + 1 < 16) P3_LOAD(row + 1);
            ln_row<true, true>(v, lane, g, bb, xout + (size_t)row * 1024, sc, sh, H + (size_t)row * 1024, (unsigned char*)(p.ws() + OFF_H8) + (size_t)row * 1024);
        }
#undef P3_LOAD
    }
    __syncthreads();
    {
        f32x4 acc[2][4]; zero_acc<2>(acc);
        const RowsF<2> ah = mk_rows<2>(p.ws() + OFF_H, 2048, row0);
        const RowsF<4> bf = mk_rows<4>(p.ws() + OFF_WR, 4096, 0);
        gemm_core<64>(acc, 16, ah, bf, lds);
        LAS float* lg = (LAS float*)lds;
        EPI_VARS(64)
        if (_wc == 0) {
#pragma unroll
            for (int m = 0; m < 2; ++m)
#pragma unroll
                for (int n = 0; n < 2; ++n)
#pragma unroll
                    for (int j = 0; j < 4; ++j) lg[EPI_ROW(64, m) * 33 + n * 16 + _fq * 4 + j] = acc[m][n][j] + acc[m][n + 2][j];
        }
        __syncthreads();
        if (tid < 64) {
            const float* rb = (const float*)p.in(28);
            float sc[32], sel[32];
#pragma unroll
            for (int e = 0; e < 32; ++e) { sc[e] = sigmoidf_(lg[tid * 33 + e]); sel[e] = sc[e] + rb[e]; }
            int bg = 0; float bgs = -INFINITY;
#pragma unroll
            for (int g = 0; g < 8; ++g) {
                float m1 = -INFINITY, m2 = -INFINITY;
#pragma unroll
                for (int j = 0; j < 4; ++j) { const float v = sel[g * 4 + j]; if (v > m1) { m2 = m1; m1 = v; } else if (v > m2) m2 = v; }
                const float gs = m1 + m2;
                if (gs > bgs) { bgs = gs; bg = g; }
            }
            int e1 = 0, e2 = 0; float v1 = -INFINITY, v2 = -INFINITY, s1 = 0.f, s2 = 0.f;
#pragma unroll
            for (int g = 0; g < 8; ++g) if (g == bg) {
#pragma unroll
                for (int j = 0; j < 4; ++j) { const float v = sel[g * 4 + j], s = sc[g * 4 + j];
                    if (v > v1) { v2 = v1; e2 = e1; s2 = s1; v1 = v; e1 = g * 4 + j; s1 = s; } else if (v > v2) { v2 = v; e2 = g * 4 + j; s2 = s; } }
            }
            const int tok = row0 + tid; const float inv = 1.f / (s1 + s2);
            float* rw = (float*)(p.ws() + OFF_RW); rw[tok * 2] = s1 * inv; rw[tok * 2 + 1] = s2 * inv;
            ((unsigned*)(p.ws() + OFF_ROUTE))[tok] = (unsigned)e1 | ((unsigned)e2 << 8);
        }
        __syncthreads();
    }
}

DEV void pd4_item(int l, int e, LAS char* lds) {
    const KA p = get_ka();
    const int tid = tidx(), lane = tid & 63, w = tid >> 6;
    LAS int* wcnt = (LAS int*)lds;
    const unsigned* route = (const unsigned*)(p.ws() + OFF_ROUTE) + w * 8192 + lane * 4;
    unsigned* list = (unsigned*)(p.ws() + OFF_LIST) + (size_t)e * T_;
    int c = 0;
#pragma unroll 1
    for (int i0 = 0; i0 < 32; i0 += 8) {
        u32x4 rv[8];
#pragma unroll
        for (int k = 0; k < 8; ++k) rv[k] = *(const u32x4*)(route + (i0 + k) * 256);
#pragma unroll
        for (int k = 0; k < 8; ++k) {
            const unsigned rr[4] = {rv[k].x, rv[k].y, rv[k].z, rv[k].w};
#pragma unroll
            for (int j = 0; j < 4; ++j) c += ((int)(rr[j] & 255u) == e || (int)((rr[j] >> 8) & 255u) == e) ? 1 : 0;
        }
    }
    c = (int)wave_sum((float)c);
    __syncthreads();
    if (lane == 0) wcnt[w] = c;
    __syncthreads();
    int off = 0, total = 0;
    for (int k = 0; k < 4; ++k) { const int v = wcnt[k]; if (k < w) off += v; total += v; }
    if (tid == 0) ((unsigned*)(p.ws() + OFF_CTRL))[CW_CNT + (l * 32 + e) * 32] = (unsigned)total;
#pragma unroll 1
    for (int i0 = 0; i0 < 32; i0 += 8) {
        u32x4 rv[8];
#pragma unroll
        for (int k = 0; k < 8; ++k) rv[k] = *(const u32x4*)(route + (i0 + k) * 256);
#pragma unroll
        for (int k = 0; k < 8; ++k) {
            const int it = i0 + k;
            const unsigned rr[4] = {rv[k].x, rv[k].y, rv[k].z, rv[k].w};
#pragma unroll
            for (int j = 0; j < 4; ++j) {
                const int m0 = (int)(rr[j] & 255u) == e, m1 = (int)((rr[j] >> 8) & 255u) == e;
                const unsigned long long bal = __ballot(m0 || m1);
                const int rank = __popcll(bal & ((1ull << lane) - 1ull));
                if (m0 || m1) list[off + rank] = (unsigned)(w * 8192 + it * 256 + lane * 4 + j) * 2u + (m1 ? 1u : 0u);
                off += __popcll(bal);
            }
        }
    }
    __syncthreads();
}

constexpr int RB_ = 160;
struct NextPe {
    const RowsF<RB_ / 32>* a; const void* bbase; unsigned bpitch; int brow0; bool valid; LAS char* lds;
    DEV bool operator()(int step, int buf) const { if (valid) stage_tile<RB_>(*a, mk_rows<4>(bbase, bpitch, brow0), step, lds, buf); return valid; }
};
DEV void pe_item(int l, int e, int rb, int padrow0, int count, LAS char* lds) {
    const KA p = get_ka();
    const int tid = tidx(); const int sr = stage_row(tid), sq = stage_q(tid);
    const unsigned* list = (const unsigned*)(p.ws() + OFF_LIST) + (size_t)e * T_ + rb * RB_;
    const int nvalid = min(RB_, count - rb * RB_);
    const char* w13 = p.ws() + OFF_E13 + (size_t)e * 512 * 1024;
    const char* w2 = p.ws() + OFF_E2 + (size_t)e * 1024 * 256;
    unsigned char* mid = (unsigned char*)(p.ws() + OFF_MIDR) + (size_t)padrow0 * 256;
    RowsF<5> ah; ah.base = p.ws() + OFF_H8;
#pragma unroll
    for (int i = 0; i < 5; ++i) {
        const int row = sr + 32 * i;
        const int tok = (int)(list[row < nvalid ? row : 0] >> 1);
        ah.off[i] = (unsigned)tok * 1024u + sq * 16;
    }
    int cbuf = 0;
#pragma unroll 1
    for (int nt = 0; nt < 4; ++nt) {
        f32x4 acc[5][4]; zero_acc<5>(acc);
        const RowsF<4> bf = mk_rows<4>(w13, 1024, nt * 128);
        NextPe nx; nx.valid = nt < 3; nx.lds = lds; nx.a = &ah; nx.bbase = w13; nx.bpitch = 1024; nx.brow0 = (nt < 3 ? nt + 1 : nt) * 128;
        gemm_core_f8<RB_>(acc, 8, ah, bf, lds, cbuf, nt > 0, nx);
        EPI_VARS(RB_)
        constexpr float s1 = 1.f / (H8_SCALE * WE8_SCALE);
#pragma unroll
        for (int m = 0; m < 5; ++m) {
            const int row = EPI_ROW(RB_, m);
#pragma unroll
            for (int n = 0; n < 2; ++n) {
                const f32x4 a = acc[m][n] * s1, g = acc[m][n + 2] * (s1 * MID8_SCALE);
                const int col = nt * 64 + _wc * 32 + n * 16 + _fq * 4;
                *(unsigned*)(mid + (size_t)row * 256 + col) = pk4_fp8(clamp8(siluf_(a[0]) * g[0]), clamp8(siluf_(a[1]) * g[1]), clamp8(siluf_(a[2]) * g[2]), clamp8(siluf_(a[3]) * g[3]));
            }
        }
    }
    __syncthreads();
    const RowsF<5> am = mk_rows<5>(mid, 256, 0);
    const float* rw = (const float*)(p.ws() + OFF_RW);
    EPI_VARS(RB_)
    unsigned orow[5]; float ow[5];
#pragma unroll
    for (int m = 0; m < 5; ++m) {
        const int row = EPI_ROW(RB_, m);
        if (row < nvalid) { const unsigned en = list[row]; orow[m] = en; ow[m] = rw[en] * (1.f / (MID8_SCALE * WE8_SCALE)); }
        else { orow[m] = 0u; ow[m] = 0.f; }
    }
    bf16_t* outb = (bf16_t*)(p.ws() + OFF_ROUT);
    cbuf = 0;
#pragma unroll 1
    for (int nt = 0; nt < 8; ++nt) {
        f32x4 acc[5][4]; zero_acc<5>(acc);
        const RowsF<4> bf = mk_rows<4>(w2, 256, nt * 128);
        NextPe nx; nx.valid = nt < 7; nx.lds = lds; nx.a = &am; nx.bbase = w2; nx.bpitch = 256; nx.brow0 = (nt < 7 ? nt + 1 : nt) * 128;
        gemm_core_f8<RB_>(acc, 2, am, bf, lds, cbuf, nt > 0, nx);
#pragma unroll
        for (int m = 0; m < 5; ++m) {
            if (EPI_ROW(RB_, m) < nvalid) {
#pragma unroll
                for (int n = 0; n < 4; ++n) st_bf4(outb + (size_t)orow[m] * 1024 + nt * 128 + EPI_COL(n), acc[m][n] * ow[m]);
            }
        }
    }
}
DEV void shared_g1_tile(int l, int it, int nxt, LAS char* lds, int& buf, bool primed) {
    const KA p = get_ka();
    const char* wl = p.ws() + OFF_W + (size_t)l * W_LAYER;
    const int mt = it >> 2, nt = it & 3;
    f32x4 acc[4][4]; zero_acc<4>(acc);
    const RowsF<4> af = mk_rows<4>(p.ws() + OFF_H8, 1024, mt * 128);
    const RowsF<4> bf = mk_rows<4>(wl + W_S13, 1024, nt * 128);
    NextRows nx; nx.valid = nxt >= 0; nx.lds = lds; nx.abase = p.ws() + OFF_H8; nx.apitch = 1024; nx.bbase = wl + W_S13; nx.bpitch = 1024;
    { const int i2 = nxt >= 0 ? nxt : it; nx.arow0 = (i2 >> 2) * 128; nx.brow0 = (i2 & 3) * 128; }
    gemm_core_f8<128>(acc, 8, af, bf, lds, buf, primed, nx);
    EPI_VARS(128)
    unsigned char* mid = (unsigned char*)(p.ws() + OFF_MIDS) + (size_t)mt * 128 * 256;
    constexpr float s1 = 1.f / (H8_SCALE * WE8_SCALE);
#pragma unroll
    for (int m = 0; m < 4; ++m) {
        const int row = EPI_ROW(128, m);
#pragma unroll
        for (int n = 0; n < 2; ++n) {
            const f32x4 a = acc[m][n] * s1, g = acc[m][n + 2] * (s1 * MID8_SCALE);
            const int col = nt * 64 + _wc * 32 + n * 16 + _fq * 4;
            *(unsigned*)(mid + (size_t)row * 256 + col) = pk4_fp8(clamp8(siluf_(a[0]) * g[0]), clamp8(siluf_(a[1]) * g[1]), clamp8(siluf_(a[2]) * g[2]), clamp8(siluf_(a[3]) * g[3]));
        }
    }
}
DEV void shared_g2_item(int l, int mt, int quarter, LAS char* lds) {
    const KA p = get_ka();
    const char* wl = p.ws() + OFF_W + (size_t)l * W_LAYER;
    const RowsF<4> am = mk_rows<4>(p.ws() + OFF_MIDS, 256, mt * 128);
    bf16_t* outb = (bf16_t*)(p.ws() + OFF_SHOUT) + (size_t)mt * 128 * 1024;
    int cbuf = 0;
#pragma unroll 1
    for (int nt = 2 * quarter; nt < 2 * quarter + 2; ++nt) {
        f32x4 acc[4][4]; zero_acc<4>(acc);
        const bool more = nt < 2 * quarter + 1;
        const RowsF<4> bf = mk_rows<4>(wl + W_S2, 256, nt * 128);
        NextRows nx; nx.valid = more; nx.lds = lds; nx.abase = p.ws() + OFF_MIDS; nx.apitch = 256; nx.arow0 = mt * 128; nx.bbase = wl + W_S2; nx.bpitch = 256; nx.brow0 = (more ? nt + 1 : nt) * 128;
        gemm_core_f8<128>(acc, 2, am, bf, lds, cbuf, nt > 2 * quarter, nx);
        EPI_VARS(128)
#pragma unroll
        for (int m = 0; m < 4; ++m)
#pragma unroll
            for (int n = 0; n < 4; ++n) st_bf4(outb + (size_t)EPI_ROW(128, m) * 1024 + nt * 128 + EPI_COL(n), acc[m][n] * (1.f / (MID8_SCALE * WE8_SCALE)));
    }
}
DEV void phase_e(int l, unsigned* qctr, LAS char* lds) {
    const KA p = get_ka();
    LAS int* slot = (LAS int*)(lds + LDS_WORK);
    LAS int* pre = slot + 4;
    const int tid = tidx();
    const unsigned* cnt = (const unsigned*)(p.ws() + OFF_CTRL) + CW_CNT + l * 32 * 32;
    if (tid < 32) pre[40 + tid] = (int)cnt[tid * 32];
    __syncthreads();
    if (tid == 0) { int a = 0; for (int e = 0; e < 32; ++e) { const int c = pre[40 + e]; pre[e] = a; a += (c + RB_ - 1) / RB_; } pre[32] = a; }
    __syncthreads();
    const int nrb = pre[32];
    const int npre = (l + 1 < NL_) ? 128 : 0;
    const int nstatic = nrb < (int)gridDim.x ? nrb : (int)gridDim.x;
    {
        const int it = vblock();
        if (it < nstatic) {
            int e = 0;
            for (int k = 0; k < 32; ++k) if (it >= pre[k + 1]) e = k + 1;
            pe_item(l, e, it - pre[e], it * RB_, pre[40 + e], lds);
        }
    }
    for (;;) {
        int it = next_item(qctr, slot) + nstatic;
        if (it >= nrb + npre + 1024) break;
        if (it < nrb) {
            int e = 0;
            for (int k = 0; k < 32; ++k) if (it >= pre[k + 1]) e = k + 1;
            pe_item(l, e, it - pre[e], it * RB_, pre[40 + e], lds);
            continue;
        }
        it -= nrb;
        if (it < npre) { ssm_pre_item(l + 1, it, lds); continue; }
        shared_g2_item(l, (it - npre) >> 2, (it - npre) & 3, lds);
    }
}

DEV void phase_f(int l) {
    const KA p = get_ka();
    const int lane = tidx() & 63, gw = blockIdx.x * 4 + (tidx() >> 6), ngw = gridDim.x * 4;
    const bf16_t* R = (const bf16_t*)(p.ws() + OFF_ROUT); const bf16_t* SH = (const bf16_t*)(p.ws() + OFF_SHOUT);
    bf16_t* H = (bf16_t*)(p.ws() + OFF_H);
    const int rpw = T_ / ngw;
    if (rpw * ngw != T_ || (4096 % rpw) != 0) return;
    const int r0 = gw * rpw, b = r0 >> 12;
    const float* ada = (const float*)(p.ws() + OFF_ADA) + ((size_t)l * 8 + b) * 6144;
    f32x4 g[4], bb[4], sc[4], sh[4], g2[4];
    ld_vec16((const float*)p.in(25) + (l * 2 + 1) * 1024, lane, g); ld_vec16((const float*)p.in(26) + (l * 2 + 1) * 1024, lane, bb);
    ld_vec16(ada + 5120, lane, g2);
    if (l + 1 < NL_) { const float* ada2 = (const float*)(p.ws() + OFF_ADA) + ((size_t)(l + 1) * 8 + b) * 6144; ld_vec16(ada2 + 0, lane, sh); ld_vec16(ada2 + 1024, lane, sc); }
    else {
#pragma unroll
        for (int j = 0; j < 4; ++j) { sh[j] = (f32x4){0.f, 0.f, 0.f, 0.f}; sc[j] = sh[j]; }
    }
    u32x2 ra[4], rb[4], rs[4]; f32x4 xv[4];
#define PF_LOAD(row) do { _Pragma("unroll") for (int j = 0; j < 4; ++j) { const int col = 4 * lane + 256 * j; \
        ra[j] = *(const u32x2*)(R + (size_t)(row) * 2048 + col); rb[j] = *(const u32x2*)(R + (size_t)(row) * 2048 + 1024 + col); rs[j] = *(const u32x2*)(SH + (size_t)(row) * 1024 + col); \
        xv[j] = *(const f32x4*)(p.out() + (size_t)(row) * 1024 + col); } } while (0)
    PF_LOAD(r0);
    for (int k = 0; k < rpw; ++k) {
        const int row = r0 + k;
        f32x4 v[4];
#pragma unroll
        for (int j = 0; j < 4; ++j) {
            const f32x4 y = (f32x4){bflo(ra[j].x) + bflo(rb[j].x) + bflo(rs[j].x), bfhi(ra[j].x) + bfhi(rb[j].x) + bfhi(rs[j].x), bflo(ra[j].y) + bflo(rb[j].y) + bflo(rs[j].y), bfhi(ra[j].y) + bfhi(rb[j].y) + bfhi(rs[j].y)};
            v[j] = xv[j] * ALPHA_ + g2[j] * y;
        }
        if (k + 1 < rpw) PF_LOAD(row + 1);
        if (l + 1 < NL_) ln_row<true, true>(v, lane, g, bb, p.out() + (size_t)row * 1024, sc, sh, nullptr, (unsigned char*)(p.ws() + OFF_H8) + (size_t)row * 1024);
        else ln_row<true, false>(v, lane, g, bb, p.out() + (size_t)row * 1024, sc, sh, nullptr);
    }
#undef PF_LOAD
}

#define XB_TMO      128
#define XB_XCNT(j)  (256  + 64 * (j))
#define XB_XSUB(j)  (1280 + 64 * (j))
#define XB_XGEN(j)  (2304 + 64 * (j))
#define XB_TOP      3328
#define XB_TOPGEN   3392
#define XCD_BAR_WORDS 3456
#define XB_SPIN_CAP (1u << 18)
DEV unsigned xb_ld(unsigned* p)              { return __hip_atomic_load(p, __ATOMIC_RELAXED, __HIP_MEMORY_SCOPE_AGENT); }
DEV unsigned xb_add(unsigned* p, unsigned v) { return __hip_atomic_fetch_add(p, v, __ATOMIC_RELAXED, __HIP_MEMORY_SCOPE_AGENT); }
DEV unsigned xb_xcc_id() { return (unsigned)__builtin_amdgcn_s_getreg((3 << 11) | 20) & 0xFu; }
#define XB_SPIN(cond, bar) do { unsigned _sp = 0; while (cond) { __builtin_amdgcn_s_sleep(1); \
    if ((++_sp & 255u) == 0u) { if (xb_ld(&(bar)[XB_TMO])) break; if (_sp > XB_SPIN_CAP) { atomicAdd(&(bar)[XB_TMO], 1u); break; } } } } while (0)
struct XcdBarrier { unsigned* bar; unsigned x; volatile LAS unsigned* st; };
DEV XcdBarrier xcd_barrier_post(unsigned* bar, volatile LAS unsigned* st) {
    XcdBarrier b; b.bar = bar; b.x = xb_xcc_id(); b.st = st;
    if (tidx() == 0) (void)xb_add(&bar[XB_XCNT(b.x)], 1u);
    return b;
}
DEV void xcd_barrier_complete(unsigned* bar, unsigned x, unsigned& nloc, unsigned& nx) {
    const unsigned G = gridDim.x * gridDim.y * gridDim.z;
    unsigned sum, cnt, mine, sp = 0u;
    for (;;) {
        sum = 0u; cnt = 0u; mine = 0u;
#pragma unroll
        for (unsigned j = 0; j < 16; ++j) { const unsigned c = xb_ld(&bar[XB_XCNT(j)]); sum += c; cnt += (c > 0u) ? 1u : 0u; mine = (j == x) ? c : mine; }
        if (sum == G) break;
        __builtin_amdgcn_s_sleep(1);
        if ((++sp & 255u) == 0u) { if (xb_ld(&bar[XB_TMO])) break; if (sp > XB_SPIN_CAP) { atomicAdd(&bar[XB_TMO], 1u); break; } }
    }
    nloc = mine > 0u ? mine : 1u; nx = cnt > 0u ? cnt : 1u;
}
DEV void xcd_barrier(const XcdBarrier& b) {
    asm volatile("s_waitcnt vmcnt(0)" ::: "memory");
    __syncthreads();
    if (tidx() == 0) {
        unsigned* bar = b.bar;
        __builtin_amdgcn_s_waitcnt(0);
        unsigned nloc = b.st[0], nx = b.st[1];
        if (nloc == 0u) { xcd_barrier_complete(bar, b.x, nloc, nx); b.st[0] = nloc; b.st[1] = nx; }
        const unsigned old = xb_add(&bar[XB_XSUB(b.x)], 1u);
        const unsigned gen = old / nloc;
        if (old + 1u == (gen + 1u) * nloc) {
            __builtin_amdgcn_fence(__ATOMIC_RELEASE, "agent");
            asm volatile("s_waitcnt vmcnt(0)" ::: "memory");
            const unsigned og = xb_add(&bar[XB_TOP], 1u);
            const unsigned tg = og / nx;
            if (og + 1u == (tg + 1u) * nx) xb_add(&bar[XB_TOPGEN], 1u);
            else XB_SPIN(xb_ld(&bar[XB_TOPGEN]) == tg, bar);
            __builtin_amdgcn_fence(__ATOMIC_ACQUIRE, "agent");
            xb_add(&bar[XB_XGEN(b.x)], 1u);
            asm volatile("s_waitcnt vmcnt(0)" ::: "memory");
        } else {
            XB_SPIN(xb_ld(&bar[XB_XGEN(b.x)]) == gen, bar);
            __builtin_amdgcn_fence(__ATOMIC_ACQUIRE, "agent");
            asm volatile("s_waitcnt vmcnt(0)" ::: "memory");
        }
    }
    __syncthreads();
}

DEV void xcd_barrier_now(LAS char* lds) {
    XcdBarrier b; b.bar = (unsigned*)(get_ka().ws() + OFF_CTRL) + CW_BAR; b.x = xb_xcc_id(); b.st = (volatile LAS unsigned*)(lds + LDS_WORK + 768);
    xcd_barrier(b);
}
#ifndef DBG_STOP
#define DBG_STOP 0
#endif
#ifndef DBG_L
#define DBG_L 0
#endif
DEV void dbg_dump(size_t off) {
    const KA p = get_ka();
    const bf16_t* src = (const bf16_t*)(p.ws() + off); float* out = p.out();
    for (size_t i = (size_t)blockIdx.x * 256 + tidx(); i < (size_t)T_ * 1024 / 4; i += (size_t)gridDim.x * 256) {
        const f32x4 v = ld_bf4(src + i * 4); *(f32x4*)(out + i * 4) = v;
    }
}
#define DBG_AT(k, off) if (DBG_STOP == (k) && l == DBG_L) { dbg_dump(off); return; }
#ifndef DBG_TIME
#define DBG_TIME 0
#endif
#define TBEG(id) unsigned long long _t0 = 0; if (((DBG_TIME >> (id)) & 1) && blockIdx.x == 0) _t0 = __builtin_amdgcn_s_memrealtime();
#define TEND(id) if (((DBG_TIME >> (id)) & 1) && blockIdx.x == 0) tacc += __builtin_amdgcn_s_memrealtime() - _t0;

__global__ void __launch_bounds__(256, 2) fwd_megakernel(Params pk) {
    extern __shared__ __attribute__((aligned(16))) unsigned char smem[];
    LAS char* lds = (LAS char*)smem;
    const int nb = gridDim.x, bid = blockIdx.x;
    unsigned long long tacc = 0;
    if (get_ka().ws() == nullptr) cg::this_grid().sync();
    {
        volatile LAS unsigned* st = (volatile LAS unsigned*)(lds + LDS_WORK + 768);
        if (tidx() < 2) st[tidx()] = 0u;
        __syncthreads();
    }
    (void)xcd_barrier_post((unsigned*)(get_ka().ws() + OFF_CTRL) + CW_BAR, (volatile LAS unsigned*)(lds + LDS_WORK + 768));
    { TBEG(0)
#pragma unroll 1
      for (int it = bid; it < 384; it += nb) ada_item(it, lds);
      xcd_barrier_now(lds); TEND(0) }
    { TBEG(1) phase_lnmod0(); phase0(lds); xcd_barrier_now(lds); TEND(1) }
    { const int l = 0; DBG_AT(20, OFF_H) DBG_AT(21, OFF_W) }
#pragma unroll 1
    for (int l = 0; l < NL_; ++l) {
        { TBEG(2) phase_a(l, lds); xcd_barrier_now(lds); TEND(2) }
        DBG_AT(1, OFF_XC) DBG_AT(2, OFF_GB) DBG_AT(3, OFF_CQ)
        { TBEG(3) phase_b(l, lds); xcd_barrier_now(lds); TEND(3) }
        DBG_AT(4, OFF_Q) DBG_AT(5, OFF_KN + 16 * MiB)
        { TBEG(4) phase_c(l, (unsigned*)(get_ka().ws() + OFF_CTRL) + CW_QUEUE + 64 * (8 + 8 * l), lds); xcd_barrier_now(lds); TEND(4) }
        DBG_AT(6, OFF_XC)
        { TBEG(5)
        { int buf = 0; bool primed = false;
          for (int it = vblock(); it < 2048; it += nb) { const int nxt = it + nb < 2048 ? it + nb : -1; pd1_tile(l, it, nxt, lds, buf, primed); primed = nxt >= 0; } }
        xcd_barrier_now(lds); TEND(5) }
        DBG_AT(7, OFF_GB)
        { TBEG(6)
        { int buf = 0; bool primed = false;
          for (int it = vblock(); it < 2048; it += nb) { const int nxt = it + nb < 2048 ? it + nb : -1; pd2_tile(l, it, nxt, lds, buf, primed); primed = nxt >= 0; } }
        xcd_barrier_now(lds); TEND(6) }
        DBG_AT(8, OFF_MERGED)
        { TBEG(7)
        { int buf = 0; bool primed = false;
          for (int it = vblock(); it < 2048; it += nb) { const int nxt = it + nb < 2048 ? it + nb : -1; pd3a_tile(l, it, nxt, lds, buf, primed); primed = nxt >= 0; } }
        xcd_barrier_now(lds); TEND(7) }
        { TBEG(14)
#pragma unroll 1
        for (int it = bid; it < 512; it += nb) pd3b_item(l, it, lds);
        xcd_barrier_now(lds); TEND(14) }
        DBG_AT(9, OFF_H)
        { TBEG(8)
#pragma unroll 1
        for (int it = bid; it < 32; it += nb) pd4_item(l, it, lds);
        { int buf = 0; bool primed = false;
          const int nw = nb > 64 ? nb - 32 : nb, w0 = nb > 64 ? bid - 32 : bid;
          if (w0 >= 0) for (int it = w0; it < 1024; it += nw) { const int nxt = it + nw < 1024 ? it + nw : -1; shared_g1_tile(l, it, nxt, lds, buf, primed); primed = nxt >= 0; } }
        xcd_barrier_now(lds); TEND(8) }
        { TBEG(9) phase_e(l, (unsigned*)(get_ka().ws() + OFF_CTRL) + CW_QUEUE + 64 * (2 * l + 1), lds); xcd_barrier_now(lds); TEND(9) }
        DBG_AT(11, OFF_ROUT) DBG_AT(12, OFF_SHOUT)
        { TBEG(10) phase_f(l); xcd_barrier_now(lds); TEND(10) }
    }
    if (DBG_TIME != 0 && bid == 0) {
        const unsigned long long t0 = __builtin_amdgcn_s_memrealtime();
        while (__builtin_amdgcn_s_memrealtime() - t0 < 4 * tacc) __builtin_amdgcn_s_sleep(8);
    }
}

extern "C" void kernel_launch(void* const* d_in, const int* in_sizes, int n_in, void* d_out, int out_size, void* d_ws, size_t ws_size, hipStream_t stream) {
    static int grid_blocks = 0;
    if (grid_blocks == 0) {
        if (n_in != 35 || ws_size < OFF_END) { fprintf(stderr, "kernel_launch: unexpected n_in %d or ws_size %zu (need %zu)\n", n_in, ws_size, (size_t)OFF_END); grid_blocks = -1; return; }
        int dev = 0, cus = 0, per_cu = 0;
        (void)hipGetDevice(&dev);
        (void)hipDeviceGetAttribute(&cus, hipDeviceAttributeMultiprocessorCount, dev);
        if (hipFuncSetAttribute((const void*)fwd_megakernel, hipFuncAttributeMaxDynamicSharedMemorySize, LDS_BYTES) != hipSuccess) { fprintf(stderr, "hipFuncSetAttribute failed\n"); grid_blocks = -1; return; }
        if (hipOccupancyMaxActiveBlocksPerMultiprocessor(&per_cu, (const void*)fwd_megakernel, 256, LDS_BYTES) != hipSuccess || per_cu < 1) { fprintf(stderr, "occupancy query failed\n"); grid_blocks = -1; return; }
        if (per_cu > 2) per_cu = 2;
        grid_blocks = cus * per_cu;
        fprintf(stderr, "kernel_launch: %d CUs x %d blocks\n", cus, per_cu);
    }
    if (grid_blocks < 0) return;
    (void)hipMemsetAsync((char*)d_ws + OFF_CTRL, 0, CTRL_BYTES, stream);
    Params p{};
    for (int i = 0; i < 35; ++i) p.in[i] = d_in[i];
    p.out = (float*)d_out; p.ws = (char*)d_ws;
    void* args[] = {&p};
    hipError_t e = hipLaunchCooperativeKernel((void*)fwd_megakernel, dim3(grid_blocks), dim3(256), args, LDS_BYTES, stream);
    if (e != hipSuccess) fprintf(stderr, "cooperative launch failed: %s (grid %d)\n", hipGetErrorString(e), grid_blocks);
}
```

```cpp
#include <hip/hip_runtime.h>
#include <hip/hip_cooperative_groups.h>
#include <cstdio>
#include <cstdint>
namespace cg = cooperative_groups;

typedef unsigned short bf16_t;
typedef short bf16x8 __attribute__((ext_vector_type(8)));
typedef float f32x4 __attribute__((ext_vector_type(4)));
typedef float f32x16 __attribute__((ext_vector_type(16)));
typedef unsigned u32x4 __attribute__((ext_vector_type(4)));
typedef unsigned u32x2 __attribute__((ext_vector_type(2)));
#define LAS __attribute__((address_space(3)))
#define GAS __attribute__((address_space(1)))
#define DEV __device__ __forceinline__

constexpr int T_ = 32768, D_ = 1024, S_ = 4096, NB_ = 8, NH_ = 8, NL_ = 2;
constexpr int NIN_ = 5536, NMIX_ = 2464;
constexpr float ALPHA_ = 1.41421356237f;
constexpr float QSCALE_ = 0.10206207261596577f * 1.4426950408889634f;

constexpr size_t MiB = 1u << 20;
constexpr size_t OFF_CTRL = 0;
constexpr size_t OFF_ADA = 64 * 1024;
constexpr size_t OFF_ROUTE = 512 * 1024;
constexpr size_t OFF_RW = 768 * 1024;
constexpr size_t OFF_CS = 1 * MiB;
constexpr size_t OFF_LIST = 5 * MiB;
constexpr size_t OFF_LAML = 9 * MiB;
constexpr size_t OFF_WR = 9 * MiB + 512 * 1024;
constexpr size_t OFF_W = 10 * MiB;
constexpr size_t W_IN = 0;
constexpr size_t W_G = W_IN + 2560 * 1024 * 2;
constexpr size_t W_GLU = W_G + 3072 * 1024 * 2;
constexpr size_t W_UQ = W_GLU + 1024 * 512 * 2;
constexpr size_t W_UK = W_UQ + 1024 * 256 * 2;
constexpr size_t W_UV = W_UK + 512 * 128 * 2;
constexpr size_t W_UPC = W_UV + 512 * 128 * 2;
constexpr size_t W_UPS = W_UPC + 1024 * 512 * 2;
constexpr size_t W_UPA = W_UPS + 1024 * 512 * 2;
constexpr size_t W_O = W_UPA + 1024 * 512 * 2;
constexpr size_t W_S13 = W_O + 1024 * 1024 * 2;
constexpr size_t W_S2 = W_S13 + 512 * 1024 * 2;
constexpr size_t W_LAYER = W_S2 + 1024 * 256 * 2;
constexpr size_t OFF_LATE = OFF_W + 2 * W_LAYER + (MiB - (2 * W_LAYER) % MiB) % MiB;
constexpr size_t OFF_E13 = OFF_LATE;
constexpr size_t OFF_E2 = OFF_E13 + 32 * MiB;
constexpr size_t OFF_SBT = OFF_E2 + 16 * MiB;
constexpr size_t OFF_SG = OFF_SBT + 24 * MiB;
constexpr size_t OFF_H = OFF_SG + 4 * MiB;
constexpr size_t OFF_ACT = OFF_H + 64 * MiB;
constexpr size_t OFF_XC = OFF_ACT;
constexpr size_t OFF_GC = OFF_XC + 32 * MiB;
constexpr size_t OFF_GB = OFF_GC + 32 * MiB;
constexpr size_t OFF_USSM = OFF_GB + 32 * MiB;
constexpr size_t OFF_CQ = OFF_USSM + 32 * MiB;
constexpr size_t OFF_CKV = OFF_CQ + 16 * MiB;
constexpr size_t OFF_KR = OFF_CKV + 8 * MiB;
constexpr size_t OFF_Q = OFF_KR + 2 * MiB;
constexpr size_t OFF_KN = OFF_Q + 48 * MiB;
constexpr size_t OFF_KRP = OFF_KN + 32 * MiB;
constexpr size_t OFF_VT = OFF_KRP + 2 * MiB;
constexpr size_t OFF_E = OFF_VT + 32 * MiB;
constexpr size_t OFF_SPREV = OFF_E;
constexpr size_t OFF_H8 = OFF_E + 16 * MiB;
constexpr size_t OFF_END = OFF_H8 + 32 * MiB;
constexpr size_t OFF_SSQP = OFF_E;
constexpr size_t OFF_ROUT = OFF_ACT;
constexpr size_t OFF_SHOUT = OFF_ROUT + 128 * MiB;
constexpr size_t OFF_MIDR = OFF_SHOUT + 64 * MiB;
constexpr size_t OFF_MIDS = OFF_MIDR + 36 * MiB;
static_assert(OFF_MIDS + 16 * MiB <= OFF_END, "moe alias");
static_assert(OFF_END <= 512 * MiB, "ws");
constexpr size_t OFF_MERGED = OFF_Q;

constexpr int CW_QUEUE = 0;
constexpr int CW_CNT = 4096;
constexpr int CW_BAR = 8192;
constexpr int CTRL_BYTES = 65536;

constexpr int LDS_WORK = 73728;
constexpr int LDS_BYTES = LDS_WORK + 1024;

struct Params { const void* in[35]; float* out; char* ws; };
#define CAS __attribute__((address_space(4)))
struct KA {
    const CAS char* k;
    __device__ __forceinline__ const void* in(int i) const { return *(const void* const CAS*)(k + 8 * i); }
    __device__ __forceinline__ float* out() const { return *(float* const CAS*)(k + 8 * 35); }
    __device__ __forceinline__ char* ws() const { return *(char* const CAS*)(k + 8 * 36); }
};
__device__ __forceinline__ KA get_ka() { const CAS char* k = (const CAS char*)__builtin_amdgcn_kernarg_segment_ptr(); asm volatile("" : "+s"(k)); KA a; a.k = k; return a; }
__device__ __forceinline__ int tidx() { int t = threadIdx.x; asm volatile("" : "+v"(t)); return t; }

typedef float f32x2_t __attribute__((ext_vector_type(2)));
typedef __bf16 bf16x2_t __attribute__((ext_vector_type(2)));
DEV unsigned pk2(float lo, float hi) { const f32x2_t v = {lo, hi}; const bf16x2_t b = __builtin_convertvector(v, bf16x2_t); return __builtin_bit_cast(unsigned, b); }
typedef int v8i_t __attribute__((ext_vector_type(8)));
typedef int v4i_t __attribute__((ext_vector_type(4)));
constexpr float GY8_SCALE = 8.f, WL8_SCALE = 32.f;
constexpr float WI8_SCALE = 32.f;
constexpr float WE8_SCALE = 64.f, MID8_SCALE = 4.f;
constexpr float H8_SCALE = 4.f, WG8_SCALE = 64.f, MG8_SCALE = 8.f, WO8_SCALE = 64.f, WU8_SCALE = 64.f;
constexpr float BR8_SCALE[3] = {2.f, 8.f, 16.f};
DEV float clamp8(float v) { return fminf(fmaxf(v, -440.f), 440.f); }
DEV unsigned pk4_fp8(float a, float b, float c, float d) { int w = __builtin_amdgcn_cvt_pk_fp8_f32(a, b, 0, false); w = __builtin_amdgcn_cvt_pk_fp8_f32(c, d, w, true); return (unsigned)w; }
DEV float bflo(unsigned w) { return __uint_as_float(w << 16); }
DEV float bfhi(unsigned w) { return __uint_as_float(w & 0xffff0000u); }
DEV float bf2f(bf16_t v) { return __uint_as_float((unsigned)v << 16); }
DEV bf16_t f2bf(float f) { return (bf16_t)(pk2(f, 0.f) & 0xffffu); }
DEV float sigmoidf_(float x) { return __builtin_amdgcn_rcpf(1.f + __expf(-x)); }
DEV float siluf_(float x) { return x * sigmoidf_(x); }
DEV float gelu_tanh(float y) { const float z = 0.7978845608028654f * (y + 0.044715f * y * y * y); const float t = 1.f - 2.f * __builtin_amdgcn_rcpf(1.f + __expf(2.f * z)); return 0.5f * y * (1.f + t); }
DEV float shx(float v, int o) { return __int_as_float(__builtin_amdgcn_ds_bpermute((((int)tidx() & 63) ^ o) << 2, __float_as_int(v))); }
DEV float wave_sum(float v) {
#pragma unroll
    for (int o = 1; o < 64; o <<= 1) v += shx(v, o);
    return v;
}
DEV int next_item(unsigned* counter, LAS int* slot) {
    __syncthreads();
    if (tidx() == 0) *slot = (int)atomicAdd(counter, 1u);
    __syncthreads();
    return *slot;
}

template <int N> struct RowsF {
    const char* base; unsigned off[N];
    DEV const char* operator()(int step, int i) const { return base + (off[i] + (unsigned)step * 128u); }
};
template <int N> struct RowsWrapF {
    const char* base; unsigned off[N];
    DEV const char* operator()(int step, int i) const { return base + (off[i] + (unsigned)(step & 15) * 128u); }
};
DEV int stage_row(int tid) { return tid >> 3; }
DEV int stage_q(int tid) { return (tid & 7) ^ ((tid >> 4) & 7); }
template <int N> DEV RowsF<N> mk_rows(const void* base, unsigned pitch_bytes, int row0) {
    RowsF<N> f; const int _t = tidx(); const int r = stage_row(_t), q = stage_q(_t);
    f.base = (const char*)base + (size_t)row0 * pitch_bytes;
#pragma unroll
    for (int i = 0; i < N; ++i) f.off[i] = (unsigned)(r + 32 * i) * pitch_bytes + q * 16;
    return f;
}

template <int BM, class AF, class BF>
DEV void stage_tile(const AF& af, const BF& bf, int step, LAS char* lds, int buf) {
    constexpr int NA = BM / 32, STAGE = BM * 128 + 16384;
    LAS char* _s = lds + buf * STAGE + (tidx() >> 6) * 1024;
#pragma unroll
    for (int _i = 0; _i < NA; ++_i) __builtin_amdgcn_global_load_lds((const GAS unsigned*)af(step, _i), (LAS unsigned*)(_s + _i * 4096), 16, 0, 0);
#pragma unroll
    for (int _i = 0; _i < 4; ++_i) __builtin_amdgcn_global_load_lds((const GAS unsigned*)bf(step, _i), (LAS unsigned*)(_s + BM * 128 + _i * 4096), 16, 0, 0);
}
struct NoNext { DEV void operator()(int) const {} DEV bool operator()(int, int) const { return false; } };
template <class AF, class BF, int BM = 128> struct NextT {
    AF a; BF b; bool valid; LAS char* lds;
    DEV void operator()(int buf) const { if (valid) stage_tile<BM>(a, b, 0, lds, buf); }
};
struct NextRows {
    const void* abase; const void* bbase; unsigned apitch, bpitch; int arow0, brow0; bool valid; LAS char* lds;
    DEV void operator()(int buf) const { if (valid) stage_tile<128>(mk_rows<4>(abase, apitch, arow0), mk_rows<4>(bbase, bpitch, brow0), 0, lds, buf); }    DEV bool operator()(int step, int buf) const { if (valid) stage_tile<128>(mk_rows<4>(abase, apitch, arow0), mk_rows<4>(bbase, bpitch, brow0), step, lds, buf); return valid; }
};
template <int BM, class AF, class BF, class NX>
DEV void gemm_core(f32x4 (&acc)[BM / 32][4], const int nsteps, const AF& af, const BF& bf, LAS char* lds, int& buf, const bool primed, const NX& next) {
    constexpr int MI = BM / 32, STAGE = BM * 128 + 16384;
    const int tid = tidx(), lane = tid & 63, wid = tid >> 6, wr = wid >> 1, wc = wid & 1, fr = lane & 15, fq = lane >> 4;
    const int sw = (fr >> 1) & 7;
    const int a_off = (wr * (BM / 2) + fr) * 128, b_off = BM * 128 + (wc * 64 + fr) * 128;
    const int o0 = (fq ^ sw) * 16, o1 = ((4 + fq) ^ sw) * 16;
    if (!primed) {
        stage_tile<BM>(af, bf, 0, lds, buf);
        asm volatile("s_waitcnt vmcnt(0)" ::: "memory");
        __syncthreads();
    }
    for (int t = 0; t < nsteps; ++t) {
        if (t + 1 < nsteps) stage_tile<BM>(af, bf, t + 1, lds, buf ^ 1); else next(buf ^ 1);
        const LAS char* sa = lds + buf * STAGE + a_off;
        const LAS char* sb = lds + buf * STAGE + b_off;
#pragma unroll
        for (int ks = 0; ks < 2; ++ks) {
            const int off = ks ? o1 : o0;
            bf16x8 fa[MI], fb[4];
#pragma unroll
            for (int m = 0; m < MI; ++m) fa[m] = *(const LAS bf16x8*)(sa + m * 2048 + off);
#pragma unroll
            for (int n = 0; n < 4; ++n) fb[n] = *(const LAS bf16x8*)(sb + n * 2048 + off);
#pragma unroll
            for (int m = 0; m < MI; ++m)
#pragma unroll
                for (int n = 0; n < 4; ++n) acc[m][n] = __builtin_amdgcn_mfma_f32_16x16x32_bf16(fb[n], fa[m], acc[m][n], 0, 0, 0);
        }
        asm volatile("s_waitcnt vmcnt(0)" ::: "memory");
        __syncthreads();
        buf ^= 1;
    }
}
template <int BM, class AF, class BF, class NX>
DEV void gemm_core_f8(f32x4 (&acc)[BM / 32][4], const int nsteps, const AF& af, const BF& bf, LAS char* lds, int& buf, const bool primed, const NX& next) {
    constexpr int MI = BM / 32, STAGE = BM * 128 + 16384;
    const int tid = tidx(), lane = tid & 63, wid = tid >> 6, wr = wid >> 1, wc = wid & 1, fr = lane & 15, fq = lane >> 4;
    const int sw = (fr >> 1) & 7;
    const int a_off = (wr * (BM / 2) + fr) * 128, b_off = BM * 128 + (wc * 64 + fr) * 128;
    const int o0 = (fq ^ sw) * 16, o1 = ((4 + fq) ^ sw) * 16;
    if (!primed) {
        stage_tile<BM>(af, bf, 0, lds, buf);
        stage_tile<BM>(af, bf, 1, lds, buf ^ 1);
        asm volatile("s_waitcnt vmcnt(%0)" :: "n"(MI + 4) : "memory");
        __builtin_amdgcn_s_barrier();
    }
#pragma unroll 1
    for (int t = 0; t < nsteps; ++t) {
        const LAS char* sa = lds + buf * STAGE + a_off;
        const LAS char* sb = lds + buf * STAGE + b_off;
        v8i_t fa[MI], fb[4];
#pragma unroll
        for (int n = 0; n < 4; ++n) { const v4i_t lo = *(const LAS v4i_t*)(sb + n * 2048 + o0), hi = *(const LAS v4i_t*)(sb + n * 2048 + o1); fb[n] = (v8i_t){lo.x, lo.y, lo.z, lo.w, hi.x, hi.y, hi.z, hi.w}; }
#pragma unroll
        for (int m = 0; m < MI; ++m) { const v4i_t lo = *(const LAS v4i_t*)(sa + m * 2048 + o0), hi = *(const LAS v4i_t*)(sa + m * 2048 + o1); fa[m] = (v8i_t){lo.x, lo.y, lo.z, lo.w, hi.x, hi.y, hi.z, hi.w}; }
        asm volatile("s_waitcnt lgkmcnt(0)" ::: "memory");
        __builtin_amdgcn_s_barrier();
        bool issued = true;
        if (t + 2 < nsteps) stage_tile<BM>(af, bf, t + 2, lds, buf); else issued = next(t + 2 - nsteps, buf);
#pragma unroll
        for (int m = 0; m < MI; ++m)
#pragma unroll
            for (int n = 0; n < 4; ++n) acc[m][n] = __builtin_amdgcn_mfma_scale_f32_16x16x128_f8f6f4(fb[n], fa[m], acc[m][n], 0, 0, 0, 0x7F7F7F7F, 0, 0x7F7F7F7F);
        if (issued) asm volatile("s_waitcnt vmcnt(%0)" :: "n"(MI + 4) : "memory"); else asm volatile("s_waitcnt vmcnt(0)" ::: "memory");
        __builtin_amdgcn_s_barrier();
        buf ^= 1;
    }
}
template <int BM, class AF, class BF>
DEV void gemm_core(f32x4 (&acc)[BM / 32][4], const int nsteps, const AF& af, const BF& bf, LAS char* lds) {
    int buf = 0; gemm_core<BM>(acc, nsteps, af, bf, lds, buf, false, NoNext());
}
DEV int vblock() { const int nb = gridDim.x, b = blockIdx.x; return (nb & 7) == 0 ? (b & 7) * (nb >> 3) + (b >> 3) : b; }
template <int MI> DEV void zero_acc(f32x4 (&acc)[MI][4]) {
#pragma unroll
    for (int m = 0; m < MI; ++m)
#pragma unroll
        for (int n = 0; n < 4; ++n) acc[m][n] = (f32x4){0.f, 0.f, 0.f, 0.f};
}
#define EPI_VARS(BM) const int _tq = tidx(); const int _lane = _tq & 63, _wid = _tq >> 6, _wr = _wid >> 1, _wc = _wid & 1, _fr = _lane & 15, _fq = _lane >> 4; (void)_wc; (void)_fq; (void)_fr; (void)_wr;
#define EPI_ROW(BM, m) (_wr * ((BM) / 2) + (m) * 16 + _fr)
#define EPI_COL(n) (_wc * 64 + (n) * 16 + _fq * 4)

DEV void st_bf4(bf16_t* dst, f32x4 v) { u32x2 w; w.x = pk2(v[0], v[1]); w.y = pk2(v[2], v[3]); *(u32x2*)dst = w; }
DEV f32x4 ld_bf4(const bf16_t* src) { const u32x2 w = *(const u32x2*)src; return (f32x4){bflo(w.x), bfhi(w.x), bflo(w.y), bfhi(w.y)}; }

template <class CP>
DEV void cvt_tile(const CP& colptr, int ld, const float* kscale, bf16_t* dst, int Kdst, int n0, int k0, LAS float* tile) {
    const int tid = tidx(), tx = tid & 63, ty = tid >> 6;
    const float* cp = colptr(n0 + tx);
    float tv[16];
#pragma unroll
    for (int i = 0; i < 16; ++i) tv[i] = cp ? cp[(size_t)(k0 + ty + 4 * i) * ld] : 0.f;
#pragma unroll
    for (int i = 0; i < 16; ++i) {
        const int k = ty + 4 * i;
        float v = tv[i];
        if (kscale) v *= kscale[k0 + k];
        tile[k * 65 + tx] = v;
    }
    __syncthreads();
#pragma unroll
    for (int j = 0; j < 2; ++j) {
        const int c = tid + 256 * j, row = c >> 3, kc = c & 7;
        const LAS float* s = tile + (kc * 8) * 65 + row;
        u32x4 o; o.x = pk2(s[0], s[65]); o.y = pk2(s[2 * 65], s[3 * 65]); o.z = pk2(s[4 * 65], s[5 * 65]); o.w = pk2(s[6 * 65], s[7 * 65]);
        *(u32x4*)(dst + (size_t)(n0 + row) * Kdst + k0 + kc * 8) = o;
    }
    __syncthreads();
}
template <class CP>
DEV void cvt_tile_f8(const CP& colptr, int ld, float scale, unsigned char* dst, int Kdst, int n0, int k0, LAS float* tile) {
    const int tid = tidx(), tx = tid & 63, ty = tid >> 6;
    const float* cp = colptr(n0 + tx);
    float tv[16];
#pragma unroll
    for (int i = 0; i < 16; ++i) tv[i] = cp ? cp[(size_t)(k0 + ty + 4 * i) * ld] : 0.f;
#pragma unroll
    for (int i = 0; i < 16; ++i) tile[(ty + 4 * i) * 65 + tx] = tv[i] * scale;
    __syncthreads();
    {
        const int row = tid >> 2, kc = tid & 3;
        const LAS float* sp = tile + (kc * 16) * 65 + row;
        u32x4 o;
        o.x = pk4_fp8(sp[0], sp[65], sp[2 * 65], sp[3 * 65]); o.y = pk4_fp8(sp[4 * 65], sp[5 * 65], sp[6 * 65], sp[7 * 65]);
        o.z = pk4_fp8(sp[8 * 65], sp[9 * 65], sp[10 * 65], sp[11 * 65]); o.w = pk4_fp8(sp[12 * 65], sp[13 * 65], sp[14 * 65], sp[15 * 65]);
        *(u32x4*)(dst + (size_t)(n0 + row) * Kdst + k0 + kc * 16) = o;
    }
    __syncthreads();
}
template <class CP>
DEV void cvt_tile_f8w(const CP& colptr, int ld, float scale, unsigned char* dst, int Kdst, int n0, int k0, LAS float* tile) {
    const int tid = tidx(), tx = tid & 63, ty = tid >> 6;
    const float* cp = colptr(n0 + tx);
#pragma unroll
    for (int h = 0; h < 2; ++h) {
        float tv[16];
#pragma unroll
        for (int i = 0; i < 16; ++i) tv[i] = cp ? cp[(size_t)(k0 + 64 * h + ty + 4 * i) * ld] : 0.f;
#pragma unroll
        for (int i = 0; i < 16; ++i) tile[(64 * h + ty + 4 * i) * 65 + tx] = tv[i] * scale;
    }
    __syncthreads();
#pragma unroll
    for (int j = 0; j < 2; ++j) {
        const int c = tid + 256 * j, row = c >> 3, kc = c & 7;
        const LAS float* sp = tile + (kc * 16) * 65 + row;
        u32x4 o;
        o.x = pk4_fp8(sp[0], sp[65], sp[2 * 65], sp[3 * 65]); o.y = pk4_fp8(sp[4 * 65], sp[5 * 65], sp[6 * 65], sp[7 * 65]);
        o.z = pk4_fp8(sp[8 * 65], sp[9 * 65], sp[10 * 65], sp[11 * 65]); o.w = pk4_fp8(sp[12 * 65], sp[13 * 65], sp[14 * 65], sp[15 * 65]);
        *(u32x4*)(dst + (size_t)(n0 + row) * Kdst + k0 + kc * 16) = o;
    }
    __syncthreads();
}
DEV void glu_map(int np, int& isgate, int& idx) { const int t = np >> 7, w = (np >> 6) & 1, within = np & 63; isgate = within >> 5; idx = t * 64 + w * 32 + (within & 31); }

DEV void cvt_early_item(int it, LAS char* lds) {
    const KA p = get_ka();
    LAS float* tile = (LAS float*)lds;
    constexpr int PER_LAYER = 2464;
    const int l = it / PER_LAYER; int r = it % PER_LAYER;
    char* wl = p.ws() + OFF_W + (size_t)l * W_LAYER;
    const float* w_in = (const float*)p.in(5) + (size_t)l * D_ * NIN_;
    if (r < 640) { const int nt = r / 16, kt = r % 16;
        cvt_tile_f8([&](int n) -> const float* { return n < NMIX_ ? w_in + n : nullptr; }, NIN_, WI8_SCALE, (unsigned char*)(wl + W_IN), 1024, nt * 64, kt * 64, tile); return; } r -= 640;
    if (r < 768) { const int nt = r / 16, kt = r % 16;
        cvt_tile_f8([&](int n) -> const float* { return w_in + NMIX_ + n; }, NIN_, WG8_SCALE, (unsigned char*)(wl + W_G), 1024, nt * 64, kt * 64, tile); return; } r -= 768;
    if (r < 128) { const int nt = r / 8, kt = r % 8; const float* w = (const float*)p.in(15) + (size_t)l * 512 * 1024;
        cvt_tile_f8([&](int n) -> const float* { int g, idx; glu_map(n, g, idx); return w + g * 512 + idx; }, 1024, WL8_SCALE, (unsigned char*)(wl + W_GLU), 512, nt * 64, kt * 64, tile); return; } r -= 128;
    if (r < 64) { const int nt = r / 4, kt = r % 4; const float* w = (const float*)p.in(17) + (size_t)l * 256 * 768;
        cvt_tile([&](int n) -> const float* { const int h = n >> 7, d = n & 127; if (d >= 96) return nullptr; int c = d; if (d >= 64) { const int i = (d - 64) >> 1, part = (d - 64) & 1; c = 64 + part * 16 + i; } return w + h * 96 + c; },
                 768, (const float*)p.in(16) + l * 256, (bf16_t*)(wl + W_UQ), 256, nt * 64, kt * 64, tile); return; } r -= 64;
    if (r < 16) { const int nt = r / 2, kt = r % 2; const float* w = (const float*)p.in(19) + (size_t)l * 128 * 512;
        cvt_tile([&](int n) -> const float* { return w + n; }, 512, (const float*)p.in(18) + l * 128, (bf16_t*)(wl + W_UK), 128, nt * 64, kt * 64, tile); return; } r -= 16;
    if (r < 16) { const int nt = r / 2, kt = r % 2; const float* w = (const float*)p.in(20) + (size_t)l * 128 * 512;
        cvt_tile([&](int n) -> const float* { return w + n; }, 512, (const float*)p.in(18) + l * 128, (bf16_t*)(wl + W_UV), 128, nt * 64, kt * 64, tile); return; } r -= 16;
    if (r < 384) { const int which = r / 128, rr = r % 128, nt = rr / 8, kt = rr % 8; const float* w = (const float*)p.in(21 + which) + (size_t)l * 512 * 1024;
        cvt_tile_f8([&](int n) -> const float* { return w + n; }, 1024, WU8_SCALE, (unsigned char*)(wl + W_UPC + (size_t)which * 1024 * 512 * 2), 512, nt * 64, kt * 64, tile); return; } r -= 384;
    if (r < 256) { const int nt = r / 16, kt = r % 16; const float* w = (const float*)p.in(24) + (size_t)l * 1024 * 1024;
        cvt_tile_f8([&](int n) -> const float* { return w + n; }, 1024, WO8_SCALE, (unsigned char*)(wl + W_O), 1024, nt * 64, kt * 64, tile); return; } r -= 256;
    if (r < 128) { const int nt = r / 16, kt = r % 16; const float* w1 = (const float*)p.in(32) + (size_t)l * 1024 * 256; const float* w3 = (const float*)p.in(33) + (size_t)l * 1024 * 256;
        cvt_tile_f8([&](int n) -> const float* { int g, idx; glu_map(n, g, idx); return (g ? w3 : w1) + idx; }, 256, WE8_SCALE, (unsigned char*)(wl + W_S13), 1024, nt * 64, kt * 64, tile); return; } r -= 128;
    { const int nt = r / 4, kt = r % 4; const float* w = (const float*)p.in(34) + (size_t)l * 256 * 1024;
        cvt_tile_f8([&](int n) -> const float* { return w + n; }, 1024, WE8_SCALE, (unsigned char*)(wl + W_S2), 256, nt * 64, kt * 64, tile); }
}
constexpr int NCVT_EARLY = 2 * 2464;
DEV void cvt_expert_item(int l, int it, LAS char* lds) {
    const KA p = get_ka();
    LAS float* tile = (LAS float*)lds;
    const int e = it / 96; int r = it % 96;
    if (r < 64) { const int nt = r >> 3, kt = r & 7;
        const float* w1 = (const float*)p.in(29) + ((size_t)l * 32 + e) * 1024 * 256; const float* w3 = (const float*)p.in(30) + ((size_t)l * 32 + e) * 1024 * 256;
        cvt_tile_f8w([&](int n) -> const float* { int g, idx; glu_map(n, g, idx); return (g ? w3 : w1) + idx; }, 256, WE8_SCALE, (unsigned char*)(p.ws() + OFF_E13) + (size_t)e * 512 * 1024, 1024, nt * 64, kt * 128, tile); return; }
    r -= 64;
    { const int nt = r >> 1, kt = r & 1; const float* w = (const float*)p.in(31) + ((size_t)l * 32 + e) * 256 * 1024;
        cvt_tile_f8w([&](int n) -> const float* { return w + n; }, 1024, WE8_SCALE, (unsigned char*)(p.ws() + OFF_E2) + (size_t)e * 1024 * 256, 256, nt * 64, kt * 128, tile); }
}

DEV void ada_item(int it, LAS char* lds) {
    const KA p = get_ka();
    LAS float* sc = (LAS float*)lds;
    LAS float* red = sc + 8192;
    const int tid = tidx(), l = it / 192, j0 = (it % 192) * 32, kq = tid >> 5, cj = tid & 31;
    const float* c = (const float*)p.in(1);
    for (int i = tid; i < 8192; i += 256) sc[i] = siluf_(c[i]);
    __syncthreads();
    const float* w = (const float*)p.in(3) + (size_t)l * 1024 * 6144 + j0 + cj;
    float a[8];
#pragma unroll
    for (int b = 0; b < 8; ++b) a[b] = 0.f;
#pragma unroll 16
    for (int k = kq * 128; k < kq * 128 + 128; ++k) {
        const float wv = w[(size_t)k * 6144];
#pragma unroll
        for (int b = 0; b < 8; ++b) a[b] += sc[b * 1024 + k] * wv;
    }
#pragma unroll
    for (int b = 0; b < 8; ++b) red[(kq * 32 + cj) * 8 + b] = a[b];
    __syncthreads();
    {
        const int b = tid >> 5, jj = tid & 31;
        float s = 0.f;
#pragma unroll
        for (int q = 0; q < 8; ++q) s += red[(q * 32 + jj) * 8 + b];
        ((float*)(p.ws() + OFF_ADA))[((size_t)l * 8 + b) * 6144 + j0 + jj] = s + ((const float*)p.in(4))[l * 6144 + j0 + jj];
    }
    __syncthreads();
}

DEV void ld_vec16(const float* pv, int lane, f32x4 (&o)[4]) {
#pragma unroll
    for (int j = 0; j < 4; ++j) o[j] = *(const f32x4*)(pv + 4 * lane + 256 * j);
}
template <bool AFF, bool MOD>
DEV void ln_row(f32x4 (&v)[4], const int lane, const f32x4 (&g)[4], const f32x4 (&bb)[4], float* xout_row, const f32x4 (&sc)[4], const f32x4 (&sh)[4], bf16_t* h_row, unsigned char* h8_row = nullptr) {
    float s = 0.f;
#pragma unroll
    for (int j = 0; j < 4; ++j) s += (v[j][0] + v[j][1]) + (v[j][2] + v[j][3]);
    float mean = wave_sum(s) * (1.f / 1024.f), q = 0.f;
#pragma unroll
    for (int j = 0; j < 4; ++j) { v[j] = v[j] - mean; q += (v[j][0] * v[j][0] + v[j][1] * v[j][1]) + (v[j][2] * v[j][2] + v[j][3] * v[j][3]); }
    float rstd = rsqrtf(wave_sum(q) * (1.f / 1024.f) + 1e-5f);
    if (AFF) {
#pragma unroll
        for (int j = 0; j < 4; ++j) { v[j] = v[j] * rstd * g[j] + bb[j]; *(f32x4*)(xout_row + 4 * lane + 256 * j) = v[j]; }
        if (!MOD) return;
        s = 0.f;
#pragma unroll
        for (int j = 0; j < 4; ++j) s += (v[j][0] + v[j][1]) + (v[j][2] + v[j][3]);
        mean = wave_sum(s) * (1.f / 1024.f); q = 0.f;
#pragma unroll
        for (int j = 0; j < 4; ++j) { v[j] = v[j] - mean; q += (v[j][0] * v[j][0] + v[j][1] * v[j][1]) + (v[j][2] * v[j][2] + v[j][3] * v[j][3]); }
        rstd = rsqrtf(wave_sum(q) * (1.f / 1024.f) + 1e-5f);
    }
    if (MOD) {
#pragma unroll
        for (int j = 0; j < 4; ++j) {
            const f32x4 o = v[j] * rstd * (sc[j] + 1.f) + sh[j];
            if (h_row) st_bf4(h_row + 4 * lane + 256 * j, o);
            if (h8_row) *(unsigned*)(h8_row + 4 * lane + 256 * j) = pk4_fp8(o[0] * H8_SCALE, o[1] * H8_SCALE, o[2] * H8_SCALE, o[3] * H8_SCALE);
        }
    }
}

DEV void ssm_pre_item(int l, int gi, LAS char* lds);
DEV void phase0(LAS char* lds) {
    const KA p = get_ka();
    const int tid = tidx(), nb = gridDim.x, bid = blockIdx.x;
    {
        const int* pos = (const int*)p.in(2); float2* cs = (float2*)(p.ws() + OFF_CS);
        for (int idx = bid * 256 + tid; idx < T_ * 16; idx += nb * 256) {
            const int t = idx >> 4, i = idx & 15;
            const float invf = powf(10000.f, -(float)(2 * i) / 32.f);
            const float ang = (float)pos[t] * invf;
            float sn, cn; sincosf(ang, &sn, &cn);
            cs[idx] = make_float2(cn, sn);
        }
    }
    {
        const float* rw = (const float*)p.in(27); bf16_t* wr = (bf16_t*)(p.ws() + OFF_WR);
        for (int idx = bid * 256 + tid; idx < 128 * 2048; idx += nb * 256) {
            const int e = idx >> 11, k = idx & 2047; bf16_t o = 0;
            if (e < 64 && k < 1024) { const float w = rw[k * 32 + (e & 31)]; const bf16_t hi = f2bf(w); o = (e < 32) ? hi : f2bf(w - bf2f(hi)); }
            wr[idx] = o;
        }
    }
    for (int it = bid; it < 736; it += nb) cvt_early_item(it < 640 ? it : 1536 + (it - 640), lds);
}
constexpr int NCVT_DEFER = NCVT_EARLY - 736;
DEV void cvt_deferred_item(int d, LAS char* lds) {
    if (d >= NCVT_DEFER) return;
    cvt_early_item(d < 896 ? 640 + d : d < 1728 ? 1632 + (d - 896) : 2464 + (d - 1728), lds);
}

DEV void phase_lnmod0() {
    const KA p = get_ka();
    const int lane = tidx() & 63, gw = blockIdx.x * 4 + (tidx() >> 6), ngw = gridDim.x * 4;
    const float* x = (const float*)p.in(0); const float* ada = (const float*)(p.ws() + OFF_ADA);
    bf16_t* H = (bf16_t*)(p.ws() + OFF_H);
    const int rpw = T_ / ngw;
    if (rpw * ngw != T_ || (4096 % rpw) != 0) return;
    const int r0 = gw * rpw, b = r0 >> 12;
    f32x4 sc[4], sh[4], dum[4];
    ld_vec16(ada + b * 6144 + 0, lane, sh); ld_vec16(ada + b * 6144 + 1024, lane, sc);
#pragma unroll
    for (int j = 0; j < 4; ++j) dum[j] = (f32x4){0.f, 0.f, 0.f, 0.f};
    f32x4 v[4], vn[4];
#pragma unroll
    for (int j = 0; j < 4; ++j) v[j] = *(const f32x4*)(x + (size_t)r0 * 1024 + 4 * lane + 256 * j);
    for (int k = 0; k < rpw; ++k) {
        const int row = r0 + k;
        if (k + 1 < rpw) {
#pragma unroll
            for (int j = 0; j < 4; ++j) vn[j] = *(const f32x4*)(x + (size_t)(row + 1) * 1024 + 4 * lane + 256 * j);
        }
        ln_row<false, true>(v, lane, dum, dum, nullptr, sc, sh, nullptr, (unsigned char*)(p.ws() + OFF_H8) + (size_t)row * 1024);
#pragma unroll
        for (int j = 0; j < 4; ++j) v[j] = vn[j];
    }
}

DEV void pa_tile(int l, int it, int nxt, LAS char* lds, int& buf, bool primed) {
    const KA p = get_ka();
    const char* wl = p.ws() + OFF_W + (size_t)l * W_LAYER;
    const int mt = it / 20, nt = it - mt * 20;
    f32x4 acc[4][4]; zero_acc<4>(acc);
    {
        const RowsF<4> af = mk_rows<4>(p.ws() + OFF_H8, 1024, mt * 128);
        const RowsF<4> bf = mk_rows<4>(wl + W_IN, 1024, nt * 128);
        NextRows nx; nx.valid = nxt >= 0; nx.lds = lds; nx.abase = p.ws() + OFF_H8; nx.bbase = wl + W_IN; nx.apitch = 1024; nx.bpitch = 1024;
        { const int i2 = nxt >= 0 ? nxt : it, m2 = i2 / 20; nx.arow0 = m2 * 128; nx.brow0 = (i2 - m2 * 20) * 128; }
        gemm_core_f8<128>(acc, 8, af, bf, lds, buf, primed, nx);
    }
    EPI_VARS(128)
    bf16_t* dst; int pitch, ncol = 128;
    if (nt < 12) { dst = (bf16_t*)(p.ws() + OFF_XC + (size_t)(nt >> 2) * 32 * MiB) + (nt & 3) * 128; pitch = 512; }
    else if (nt < 16) { dst = (bf16_t*)(p.ws() + OFF_USSM) + (nt - 12) * 128; pitch = 512; }
    else if (nt < 18) { dst = (bf16_t*)(p.ws() + OFF_CQ) + (nt - 16) * 128; pitch = 256; }
    else if (nt < 19) { dst = (bf16_t*)(p.ws() + OFF_CKV); pitch = 128; }
    else { dst = (bf16_t*)(p.ws() + OFF_KR); pitch = 32; ncol = 32; }
    float* ssqp = (float*)(p.ws() + OFF_SSQP);
#pragma unroll
    for (int m = 0; m < 4; ++m) {
        const int row = mt * 128 + EPI_ROW(128, m);
        float sq = 0.f;
#pragma unroll
        for (int n = 0; n < 4; ++n) {
            const int col = EPI_COL(n);
            const f32x4 v = acc[m][n] * (1.f / (H8_SCALE * WI8_SCALE));
            if (nt >= 12 && nt < 16) st_bf4((bf16_t*)(p.ws() + OFF_USSM) + ((size_t)((nt - 12) * 8 + _wc * 4 + n) * T_ + row) * 16 + 4 * _fq, v);
            else if (col < ncol) st_bf4(dst + (size_t)row * pitch + col, v);
            sq += (v[0] * v[0] + v[1] * v[1]) + (v[2] * v[2] + v[3] * v[3]);
        }
        if (nt >= 16 && nt < 19) {
            sq += shx(sq, 16); sq += shx(sq, 32);
            if (_fq == 0) ssqp[(size_t)row * 8 + (nt - 16) * 2 + _wc] = sq;
        }
    }
}

DEV void ssm_pre_item(int l, int gi, LAS char* lds) {
    const int g = gi >> 2, part = gi & 3;
    const KA p = get_ka();
    LAS float* pwr = (LAS float*)lds;
    LAS float* pwi = pwr + 33 * 64;
    LAS float* ffr = pwi + 33 * 64;
    LAS float* ffi = ffr + 64;
    LAS float* ktab = ffi + 64;
    const int tid = tidx(), lg = l * 32 + g;
    const float dt = expf(((const float*)p.in(14))[lg]);
    const float* a_re = (const float*)p.in(7) + lg * 64; const float* a_im = (const float*)p.in(8) + lg * 64;
    const float* b_re = (const float*)p.in(9) + (size_t)lg * 64 * 16; const float* b_im = (const float*)p.in(10) + (size_t)lg * 64 * 16;
    const float* c_re = (const float*)p.in(11) + (size_t)lg * 16 * 64; const float* c_im = (const float*)p.in(12) + (size_t)lg * 16 * 64;
    for (int i = tid; i < 33 * 64; i += 256) {
        const int e = i >> 6, n = i & 63;
        const float mag = expf(a_re[n] * dt * (float)e); float sn, cn; sincosf(a_im[n] * dt * (float)e, &sn, &cn);
        pwr[i] = mag * cn; pwi[i] = mag * sn;
    }
    if (tid < 64) {
        const int n = tid; const float ar = a_re[n], ai = a_im[n];
        const float mag = expf(ar * dt); float sn, cn; sincosf(ai * dt, &sn, &cn);
        const float lre = mag * cn, lim = mag * sn, den = ar * ar + ai * ai, nr = lre - 1.f, ni = lim;
        ffr[n] = (nr * ar + ni * ai) / den; ffi[n] = (ni * ar - nr * ai) / den;
    }
    __syncthreads();
    {
        const int pp = tid >> 4, q = tid & 15;
        float acc[32];
#pragma unroll
        for (int k = 0; k < 32; ++k) acc[k] = 0.f;
        for (int n = 0; n < 64; ++n) {
            const float cre = c_re[pp * 64 + n], cim = c_im[pp * 64 + n];
            const float br = b_re[n * 16 + q], bi = b_im[n * 16 + q];
            const float fr = ffr[n], fi = ffi[n];
            const float bbr = fr * br - fi * bi, bbi = fr * bi + fi * br;
            const float wre = cre * bbr - cim * bbi, wim = cre * bbi + cim * bbr;
#pragma unroll
            for (int k = 0; k < 32; ++k) acc[k] += wre * pwr[k * 64 + n] - wim * pwi[k * 64 + n];
        }
#pragma unroll
        for (int k = 0; k < 32; ++k) ktab[k * 256 + pp * 16 + q] = acc[k];
    }
    __syncthreads();
    bf16_t* BT = (bf16_t*)(p.ws() + OFF_SBT) + (size_t)g * 512 * 768;
    for (int c = part * 128 * 64 + tid; c < (part + 1) * 128 * 64; c += 256) {
        const int row = c >> 6, kc = c & 63, i = row >> 4, pp = row & 15, j = kc >> 1, q0 = (kc & 1) * 8;
        u32x4 o = (u32x4){0u, 0u, 0u, 0u};
        if (i >= j) { const LAS float* s = ktab + (i - j) * 256 + pp * 16 + q0; o.x = pk2(s[0], s[1]); o.y = pk2(s[2], s[3]); o.z = pk2(s[4], s[5]); o.w = pk2(s[6], s[7]); }
        *(u32x4*)(BT + (size_t)row * 768 + kc * 8) = o;
    }
    for (int c = part * 128 * 16 + tid; c < (part + 1) * 128 * 16; c += 256) {
        const int row = c >> 4, kc2 = c & 15, i = row >> 4, pp = row & 15, n0 = (kc2 & 7) * 8, reim2 = kc2 >> 3;
        float v[8];
#pragma unroll
        for (int e = 0; e < 8; ++e) {
            const int n = n0 + e; const float cre = c_re[pp * 64 + n], cim = c_im[pp * 64 + n], lr = pwr[(i + 1) * 64 + n], li = pwi[(i + 1) * 64 + n];
            v[e] = reim2 == 0 ? (cre * lr - cim * li) : -(cre * li + cim * lr);
        }
        u32x4 o; o.x = pk2(v[0], v[1]); o.y = pk2(v[2], v[3]); o.z = pk2(v[4], v[5]); o.w = pk2(v[6], v[7]);
        *(u32x4*)(BT + (size_t)row * 768 + 512 + kc2 * 8) = o;
        *(u32x4*)(BT + (size_t)row * 768 + 640 + kc2 * 8) = o;
    }
    bf16_t* SG = (bf16_t*)(p.ws() + OFF_SG) + (size_t)g * 128 * 512;
    for (int c = part * 32 * 64 + tid; c < (part + 1) * 32 * 64; c += 256) {
        const int row = c >> 6, kc = c & 63, n = row & 63, reim = row >> 6, j = kc >> 1, q0 = (kc & 1) * 8;
        const float lr = pwr[(31 - j) * 64 + n], li = pwi[(31 - j) * 64 + n], fr = ffr[n], fi = ffi[n];
        float v[8];
#pragma unroll
        for (int e = 0; e < 8; ++e) {
            const float br = b_re[n * 16 + q0 + e], bi = b_im[n * 16 + q0 + e];
            const float bbr = fr * br - fi * bi, bbi = fr * bi + fi * br;
            v[e] = reim == 0 ? (lr * bbr - li * bbi) : (lr * bbi + li * bbr);
        }
        u32x4 o; o.x = pk2(v[0], v[1]); o.y = pk2(v[2], v[3]); o.z = pk2(v[4], v[5]); o.w = pk2(v[6], v[7]);
        *(u32x4*)(SG + (size_t)row * 512 + kc * 8) = o;
    }
    if (tid < 64 && part == 0) ((float2*)(p.ws() + OFF_LAML))[g * 64 + tid] = make_float2(pwr[32 * 64 + tid], pwi[32 * 64 + tid]);
    __syncthreads();
}

DEV void phase_a(int l, LAS char* lds) {
    const int nb = gridDim.x, bid = blockIdx.x;
    int buf = 0; bool primed = false;
#pragma unroll 1
    for (int it = vblock(); it < 256 * 20; it += nb) { const int nxt = it + nb < 256 * 20 ? it + nb : -1; pa_tile(l, it, nxt, lds, buf, primed); primed = nxt >= 0; }
}

DEV void rows_rinv(const bf16_t* base, int ncols, int row0, LAS char* lds) {
    LAS float* tbl = (LAS float*)(lds + LDS_WORK + 256);
    const int tid = tidx(), row = tid >> 1, half = tid & 1, n = ncols >> 1;
    const bf16_t* src = base + (size_t)(row0 + row) * ncols + half * n;
    float s = 0.f;
    for (int c = 0; c < n; c += 8) {
        const u32x4 w = *(const u32x4*)(src + c);
        const float a0 = bflo(w.x), a1 = bfhi(w.x), a2 = bflo(w.y), a3 = bfhi(w.y), a4 = bflo(w.z), a5 = bfhi(w.z), a6 = bflo(w.w), a7 = bfhi(w.w);
        s += (a0 * a0 + a1 * a1) + (a2 * a2 + a3 * a3) + (a4 * a4 + a5 * a5) + (a6 * a6 + a7 * a7);
    }
    s += shx(s, 1);
    __syncthreads();
    if (!half) tbl[row] = rsqrtf(s / (float)ncols + 1e-6f);
    __syncthreads();
}
DEV void pb_q_tile(int l, int it, int nxt, LAS char* lds, int& buf, bool primed) {
    const KA p = get_ka();
    const char* wl = p.ws() + OFF_W + (size_t)l * W_LAYER;
    const int mt = it >> 3, h = it & 7;
    float rq[4];
    { EPI_VARS(128) const float* ssqp = (const float*)(p.ws() + OFF_SSQP);
#pragma unroll
      for (int m = 0; m < 4; ++m) { const f32x4 s4 = *(const f32x4*)(ssqp + (size_t)(mt * 128 + EPI_ROW(128, m)) * 8); rq[m] = (s4[0] + s4[1]) + (s4[2] + s4[3]); } }
    f32x4 acc[4][4]; zero_acc<4>(acc);
    const RowsF<4> af = mk_rows<4>(p.ws() + OFF_CQ, 512, mt * 128);
    const RowsF<4> bf = mk_rows<4>(wl + W_UQ, 512, h * 128);
    NextT<RowsF<4>, RowsF<4> > nx; nx.valid = nxt >= 0; nx.lds = lds;
    { const int i2 = nxt >= 0 ? nxt : it; nx.a = mk_rows<4>(p.ws() + OFF_CQ, 512, (i2 >> 3) * 128); nx.b = mk_rows<4>(wl + W_UQ, 512, (i2 & 7) * 128); }
    gemm_core<128>(acc, 4, af, bf, lds, buf, primed, nx);
    EPI_VARS(128)
    const float2* cs = (const float2*)(p.ws() + OFF_CS); bf16_t* Q = (bf16_t*)(p.ws() + OFF_Q);
#pragma unroll
    for (int m = 0; m < 4; ++m) {
        const int rloc = EPI_ROW(128, m), row = mt * 128 + rloc, b = row >> 12, s = row & 4095;
        const float rinv = rsqrtf(rq[m] * (1.f / 256.f) + 1e-6f) * QSCALE_;
#pragma unroll
        for (int n = 0; n < 4; ++n) {
            const int d = EPI_COL(n);
            if (d < 96) {
                f32x4 v = acc[m][n] * rinv;
                if (d >= 64) {
                    const int i = (d - 64) >> 1; const float2 c0 = cs[row * 16 + i], c1 = cs[row * 16 + i + 1];
                    v = (f32x4){v[0] * c0.x - v[1] * c0.y, v[0] * c0.y + v[1] * c0.x, v[2] * c1.x - v[3] * c1.y, v[2] * c1.y + v[3] * c1.x};
                }
                st_bf4(Q + ((size_t)(b * 8 + h) * 4096 + s) * 96 + d, v);
            }
        }
    }
}
DEV void pb_k_tile(int l, int it, int nxt, LAS char* lds, int& buf, bool primed) {
    const KA p = get_ka();
    const char* wl = p.ws() + OFF_W + (size_t)l * W_LAYER;
    const int mt = it >> 2, nt = it & 3;
    float rk[4];
    { EPI_VARS(128) const float* ssqp = (const float*)(p.ws() + OFF_SSQP);
#pragma unroll
      for (int m = 0; m < 4; ++m) { const float2 s2 = *(const float2*)(ssqp + (size_t)(mt * 128 + EPI_ROW(128, m)) * 8 + 4); rk[m] = s2.x + s2.y; } }
    f32x4 acc[4][4]; zero_acc<4>(acc);
    const RowsF<4> af = mk_rows<4>(p.ws() + OFF_CKV, 256, mt * 128);
    const RowsF<4> bf = mk_rows<4>(wl + W_UK, 256, nt * 128);
    NextT<RowsF<4>, RowsF<4> > nx; nx.valid = nxt >= 0; nx.lds = lds;
    { const int i2 = nxt >= 0 ? nxt : it; nx.a = mk_rows<4>(p.ws() + OFF_CKV, 256, (i2 >> 2) * 128); nx.b = mk_rows<4>(wl + W_UK, 256, (i2 & 3) * 128); }
    gemm_core<128>(acc, 2, af, bf, lds, buf, primed, nx);
    EPI_VARS(128)
    bf16_t* KN = (bf16_t*)(p.ws() + OFF_KN);
#pragma unroll
    for (int m = 0; m < 4; ++m) {
        const int rloc = EPI_ROW(128, m), row = mt * 128 + rloc, b = row >> 12, s = row & 4095;
        const float rinv = rsqrtf(rk[m] * (1.f / 128.f) + 1e-6f);
#pragma unroll
        for (int n = 0; n < 4; ++n) {
            const int col = nt * 128 + EPI_COL(n), h = col >> 6, d = col & 63;
            st_bf4(KN + ((size_t)(b * 8 + h) * 4096 + s) * 64 + d, acc[m][n] * rinv);
        }
    }
}
DEV void pb_v_tile(int l, int it, int nxt, LAS char* lds, int& buf, bool primed) {
    const KA p = get_ka();
    const char* wl = p.ws() + OFF_W + (size_t)l * W_LAYER;
    const int mt = it & 3, nt = it >> 2;
    f32x4 rv[4];
    { EPI_VARS(128) const float* ssqp = (const float*)(p.ws() + OFF_SSQP);
#pragma unroll
      for (int n = 0; n < 4; ++n)
#pragma unroll
        for (int j = 0; j < 4; ++j) { const float2 s2 = *(const float2*)(ssqp + (size_t)(nt * 128 + EPI_COL(n) + j) * 8 + 4); rv[n][j] = s2.x + s2.y; } }
    f32x4 acc[4][4]; zero_acc<4>(acc);
    const RowsF<4> af = mk_rows<4>(wl + W_UV, 256, mt * 128);
    const RowsF<4> bf = mk_rows<4>(p.ws() + OFF_CKV, 256, nt * 128);
    NextT<RowsF<4>, RowsF<4> > nx; nx.valid = nxt >= 0; nx.lds = lds;
    { const int i2 = nxt >= 0 ? nxt : it; nx.a = mk_rows<4>(wl + W_UV, 256, (i2 & 3) * 128); nx.b = mk_rows<4>(p.ws() + OFF_CKV, 256, (i2 >> 2) * 128); }
    gemm_core<128>(acc, 2, af, bf, lds, buf, primed, nx);
    EPI_VARS(128)
    bf16_t* VT = (bf16_t*)(p.ws() + OFF_VT);
#pragma unroll
    for (int n = 0; n < 4; ++n) {
        const int cloc = EPI_COL(n), tok = nt * 128 + cloc, b = tok >> 12, s = tok & 4095;
        const f32x4 rinv = (f32x4){rsqrtf(rv[n][0] * (1.f / 128.f) + 1e-6f), rsqrtf(rv[n][1] * (1.f / 128.f) + 1e-6f), rsqrtf(rv[n][2] * (1.f / 128.f) + 1e-6f), rsqrtf(rv[n][3] * (1.f / 128.f) + 1e-6f)};
#pragma unroll
        for (int m = 0; m < 4; ++m) {
            const int r = mt * 128 + EPI_ROW(128, m), h = r >> 6, dv = r & 63;
            st_bf4(VT + ((size_t)(b * 8 + h) * 64 + dv) * 4096 + s, acc[m][n] * rinv);
        }
    }
}
DEV void pb_elem_item(int l, int it) {
    const KA p = get_ka();
    const int tid = tidx(), t0 = it * 64;
    const bf16_t* xc = (const bf16_t*)(p.ws() + OFF_XC); const bf16_t* gc = (const bf16_t*)(p.ws() + OFF_GC); bf16_t* gbp = (bf16_t*)(p.ws() + OFF_GB);
    const float* cw = (const float*)p.in(6) + l * 3 * 512;
    {
        const int ch = (tid & 63) * 8;
        float w0[8], w1[8], w2[8];
#pragma unroll
        for (int e = 0; e < 8; ++e) { w0[e] = cw[ch + e]; w1[e] = cw[512 + ch + e]; w2[e] = cw[1024 + ch + e]; }
        for (int tt = tid >> 6; tt < 64; tt += 4) {
            const int t = t0 + tt, s = t & 4095;
            const size_t o = (size_t)t * 512 + ch;
            float u0[8], u1[8], u2[8], gbv[8];
            {
                const u32x4 a = *(const u32x4*)(xc + o), g = *(const u32x4*)(gc + o), gb = *(const u32x4*)(gbp + o);
                const unsigned aw[4] = {a.x, a.y, a.z, a.w}, gw[4] = {g.x, g.y, g.z, g.w}, bw[4] = {gb.x, gb.y, gb.z, gb.w};
#pragma unroll
                for (int e = 0; e < 4; ++e) { u2[2 * e] = bflo(aw[e]) * bflo(gw[e]); u2[2 * e + 1] = bfhi(aw[e]) * bfhi(gw[e]); gbv[2 * e] = bflo(bw[e]); gbv[2 * e + 1] = bfhi(bw[e]); }
            }
            if (s >= 1) {
                const u32x4 a = *(const u32x4*)(xc + o - 512), g = *(const u32x4*)(gc + o - 512);
                const unsigned aw[4] = {a.x, a.y, a.z, a.w}, gw[4] = {g.x, g.y, g.z, g.w};
#pragma unroll
                for (int e = 0; e < 4; ++e) { u1[2 * e] = bflo(aw[e]) * bflo(gw[e]); u1[2 * e + 1] = bfhi(aw[e]) * bfhi(gw[e]); }
            } else {
#pragma unroll
                for (int e = 0; e < 8; ++e) u1[e] = 0.f;
            }
            if (s >= 2) {
                const u32x4 a = *(const u32x4*)(xc + o - 1024), g = *(const u32x4*)(gc + o - 1024);
                const unsigned aw[4] = {a.x, a.y, a.z, a.w}, gw[4] = {g.x, g.y, g.z, g.w};
#pragma unroll
                for (int e = 0; e < 4; ++e) { u0[2 * e] = bflo(aw[e]) * bflo(gw[e]); u0[2 * e + 1] = bfhi(aw[e]) * bfhi(gw[e]); }
            } else {
#pragma unroll
                for (int e = 0; e < 8; ++e) u0[e] = 0.f;
            }
            float ov[8];
#pragma unroll
            for (int e = 0; e < 8; ++e) ov[e] = gbv[e] * (w0[e] * u0[e] + w1[e] * u1[e] + w2[e] * u2[e]);
            u32x2 o2; o2.x = pk4_fp8(clamp8(ov[0] * 2.f), clamp8(ov[1] * 2.f), clamp8(ov[2] * 2.f), clamp8(ov[3] * 2.f)); o2.y = pk4_fp8(clamp8(ov[4] * 2.f), clamp8(ov[5] * 2.f), clamp8(ov[6] * 2.f), clamp8(ov[7] * 2.f));
            *(u32x2*)((unsigned char*)(p.ws() + OFF_H) + o) = o2;
        }
    }
    {
        const bf16_t* kr = (const bf16_t*)(p.ws() + OFF_KR); const float2* cs = (const float2*)(p.ws() + OFF_CS); bf16_t* KRP = (bf16_t*)(p.ws() + OFF_KRP);
        for (int idx = tid; idx < 64 * 16; idx += 256) {
            const int t = t0 + (idx >> 4), i = idx & 15;
            const float x1 = bf2f(kr[t * 32 + i]), x2 = bf2f(kr[t * 32 + 16 + i]); const float2 c = cs[t * 16 + i];
            *(unsigned*)(KRP + (size_t)t * 32 + 2 * i) = pk2(x1 * c.x - x2 * c.y, x1 * c.y + x2 * c.x);
        }
    }
}
DEV void phase_b(int l, LAS char* lds) {
    const int nb = gridDim.x, bid = blockIdx.x;
    for (int it = bid; it < 512; it += nb) pb_elem_item(l, it);
    const int vb = vblock();
    { int buf = 0; bool primed = false;
      for (int it = vb; it < 2048; it += nb) { const int nxt = it + nb < 2048 ? it + nb : -1; pb_q_tile(l, it, nxt, lds, buf, primed); primed = nxt >= 0; } }
    { int buf = 0; bool primed = false;
      for (int it = vb; it < 1024; it += nb) { const int nxt = it + nb < 1024 ? it + nb : -1; pb_k_tile(l, it, nxt, lds, buf, primed); primed = nxt >= 0; } }
    { int buf = 0; bool primed = false;
      for (int it = vb; it < 1024; it += nb) { const int nxt = it + nb < 1024 ? it + nb : -1; pb_v_tile(l, it, nxt, lds, buf, primed); primed = nxt >= 0; } }
}

DEV void attn_item(int b, int h, int qb, LAS char* lds) {
    const KA p = get_ka();
    constexpr int KN = 0, KR = 8192, VV = 12288, ST = 20480;
    const int tid = tidx(), lane = tid & 63, wid = tid >> 6, r = lane & 31, hh = lane >> 5;
    const int bh = b * 8 + h, q0 = qb * 128 + wid * 32;
    const bf16_t* Qp = (const bf16_t*)(p.ws() + OFF_Q) + ((size_t)bh * 4096 + q0 + r) * 96;
    bf16x8 qf[6];
#pragma unroll
    for (int s = 0; s < 6; ++s) qf[s] = *(const bf16x8*)(Qp + 16 * s + 8 * hh);
    const char* Kg = p.ws() + OFF_KN + (size_t)bh * 4096 * 128;
    const char* Rg = p.ws() + OFF_KRP + (size_t)b * 4096 * 64;
    const char* Vg = p.ws() + OFF_VT + (size_t)bh * 64 * 8192;
    const char* kn_src[2]; const char* v_src[2]; const char* kr_src;
#pragma unroll
    for (int i = 0; i < 2; ++i) {
        const int pp = tid + 256 * i, row = pp >> 3, s = pp & 7, q = s ^ ((row >> 1) & 7);
        const int key = (row & ~12) | ((row & 4) << 1) | ((row & 8) >> 1);
        kn_src[i] = Kg + (size_t)key * 128 + q * 16;
        v_src[i] = Vg + (size_t)row * 8192 + q * 16;
    }
    {
        const int row = tid >> 2, s = tid & 3, g = (row >> 2) & 3, f = (0x78 >> (2 * g)) & 3, q = s ^ f;
        const int key = (row & ~12) | ((row & 4) << 1) | ((row & 8) >> 1);
        kr_src = Rg + (size_t)key * 64 + q * 16;
    }
    const int wbase = wid * 1024;
#define AT_STAGE(t, buf) do { LAS char* _s = lds + (buf) * ST + wbase; \
        __builtin_amdgcn_global_load_lds((const GAS unsigned*)(kn_src[0] + (size_t)(t) * (64 * 128)), (LAS unsigned*)(_s + KN), 16, 0, 0); \
        __builtin_amdgcn_global_load_lds((const GAS unsigned*)(kn_src[1] + (size_t)(t) * (64 * 128)), (LAS unsigned*)(_s + KN + 4096), 16, 0, 0); \
        __builtin_amdgcn_global_load_lds((const GAS unsigned*)(kr_src + (size_t)(t) * (64 * 64)), (LAS unsigned*)(_s + KR), 16, 0, 0); \
        __builtin_amdgcn_global_load_lds((const GAS unsigned*)(v_src[0] + (size_t)(t) * 128), (LAS unsigned*)(_s + VV), 16, 0, 0); \
        __builtin_amdgcn_global_load_lds((const GAS unsigned*)(v_src[1] + (size_t)(t) * 128), (LAS unsigned*)(_s + VV + 4096), 16, 0, 0); } while (0)
    f32x16 o0, o1;
#pragma unroll
    for (int i = 0; i < 16; ++i) { o0[i] = 0.f; o1[i] = 0.f; }
    float mrun = -INFINITY, lrun = 0.f;
    const int ntiles = 2 * qb + 2;
    const int swn = (r >> 1) & 7;
    const int fro = (0x78 >> (2 * ((r >> 2) & 3))) & 3;
    AT_STAGE(0, 0);
    AT_STAGE(1, 1);
    asm volatile("s_waitcnt vmcnt(5)" ::: "memory");
    __builtin_amdgcn_s_barrier();
    int buf = 0;
    for (int t = 0; t < ntiles; ++t) {
        const bool more = t + 2 < ntiles;
        if (more) { const int b2 = buf == 0 ? 2 : buf - 1; AT_STAGE(t + 2, b2); }
        const int key0 = t * 64;
        if (key0 <= q0 + 31) {
            const LAS char* base = lds + buf * ST;
            f32x16 st[2];
            bf16x8 kfr[2][6];
#pragma unroll
            for (int kb = 0; kb < 2; ++kb) {
                const LAS char* kn = base + KN + (kb * 32 + r) * 128;
                const LAS char* kr = base + KR + (kb * 32 + r) * 64;
#pragma unroll
                for (int s = 0; s < 4; ++s) kfr[kb][s] = *(const LAS bf16x8*)(kn + (((2 * s + hh) ^ swn) * 16));
#pragma unroll
                for (int s = 0; s < 2; ++s) kfr[kb][4 + s] = *(const LAS bf16x8*)(kr + (((2 * s + hh) ^ fro) * 16));
            }
            __builtin_amdgcn_sched_barrier(0);
#pragma unroll
            for (int kb = 0; kb < 2; ++kb)
#pragma unroll
                for (int i = 0; i < 16; ++i) st[kb][i] = 0.f;
#pragma unroll
            for (int s = 0; s < 6; ++s)
#pragma unroll
                for (int kb = 0; kb < 2; ++kb) st[kb] = __builtin_amdgcn_mfma_f32_32x32x16_bf16(kfr[kb][s], qf[s], st[kb], 0, 0, 0);
            bf16x8 vfr[2][2][2];
            {
                const LAS char* v0 = base + VV + r * 128;
                const LAS char* v1 = base + VV + (32 + r) * 128;
#pragma unroll
                for (int kb = 0; kb < 2; ++kb)
#pragma unroll
                    for (int s2 = 0; s2 < 2; ++s2) {
                        const int c = (4 * kb + 2 * s2 + hh) ^ swn;
                        vfr[kb][s2][0] = *(const LAS bf16x8*)(v0 + c * 16);
                        vfr[kb][s2][1] = *(const LAS bf16x8*)(v1 + c * 16);
                    }
            }
            __builtin_amdgcn_sched_barrier(0);
            if (key0 + 63 > q0) {
                const int qi = q0 + r;
#pragma unroll
                for (int kb = 0; kb < 2; ++kb)
#pragma unroll
                    for (int i = 0; i < 16; ++i) {
                        const int key = key0 + kb * 32 + (i & 3) + 4 * ((i >> 2) & 1) + 8 * hh + 16 * (i >> 3);
                        if (key > qi) st[kb][i] = -INFINITY;
                    }
            }
            float tm = st[0][0];
#pragma unroll
            for (int i = 1; i < 16; ++i) tm = fmaxf(tm, st[0][i]);
#pragma unroll
            for (int i = 0; i < 16; ++i) tm = fmaxf(tm, st[1][i]);
            tm = fmaxf(tm, shx(tm, 32));
            const float mnew = fmaxf(mrun, tm);
            const float alpha = __builtin_amdgcn_exp2f(mrun - mnew);
            mrun = mnew;
            float ps = 0.f;
#pragma unroll
            for (int kb = 0; kb < 2; ++kb)
#pragma unroll
                for (int i = 0; i < 16; ++i) { const float e = __builtin_amdgcn_exp2f(st[kb][i] - mnew); st[kb][i] = e; ps += e; }
            lrun = lrun * alpha + ps;
#pragma unroll
            for (int i = 0; i < 16; ++i) { o0[i] *= alpha; o1[i] *= alpha; }
#pragma unroll
            for (int kb = 0; kb < 2; ++kb)
#pragma unroll
                for (int s2 = 0; s2 < 2; ++s2) {
                    union { u32x4 u; bf16x8 v; } pb;
                    pb.u.x = pk2(st[kb][8 * s2 + 0], st[kb][8 * s2 + 1]); pb.u.y = pk2(st[kb][8 * s2 + 2], st[kb][8 * s2 + 3]);
                    pb.u.z = pk2(st[kb][8 * s2 + 4], st[kb][8 * s2 + 5]); pb.u.w = pk2(st[kb][8 * s2 + 6], st[kb][8 * s2 + 7]);
                    o0 = __builtin_amdgcn_mfma_f32_32x32x16_bf16(vfr[kb][s2][0], pb.v, o0, 0, 0, 0);
                    o1 = __builtin_amdgcn_mfma_f32_32x32x16_bf16(vfr[kb][s2][1], pb.v, o1, 0, 0, 0);
                }
        }
        if (more) asm volatile("s_waitcnt vmcnt(5)" ::: "memory"); else asm volatile("s_waitcnt vmcnt(0)" ::: "memory");
        __builtin_amdgcn_s_barrier();
        buf = buf == 2 ? 0 : buf + 1;
    }
#undef AT_STAGE
    const float ltot = lrun + shx(lrun, 32);
    const float inv = 1.f / ltot;
    unsigned char* O = (unsigned char*)(p.ws() + OFF_XC) + (size_t)(b * 4096 + q0 + r) * 512 + h * 64;
    const float inv8 = inv * 16.f;
#pragma unroll
    for (int g4 = 0; g4 < 4; ++g4) {
        const int dv = 8 * g4 + 4 * hh;
        *(unsigned*)(O + dv) = pk4_fp8(clamp8(o0[4 * g4] * inv8), clamp8(o0[4 * g4 + 1] * inv8), clamp8(o0[4 * g4 + 2] * inv8), clamp8(o0[4 * g4 + 3] * inv8));
        *(unsigned*)(O + 32 + dv) = pk4_fp8(clamp8(o1[4 * g4] * inv8), clamp8(o1[4 * g4 + 1] * inv8), clamp8(o1[4 * g4 + 2] * inv8), clamp8(o1[4 * g4 + 3] * inv8));
    }
}

struct SsmAF { const char* ub; const char* sb; unsigned pu[4]; unsigned ps[4]; int n1;
    DEV const char* operator()(int step, int i) const { return step < n1 ? ub + (pu[i] + (unsigned)step * 128u) : sb + (ps[i] + (unsigned)(step - n1) * 128u); } };
struct SsmBF { const char* bb; unsigned pb[4]; int n1;
    DEV const char* operator()(int step, int i) const { return bb + (pb[i] + (step < n1 ? (unsigned)step * 128u : 1024u + (unsigned)(step - n1) * 128u)); } };
DEV void ssm_item(int l, int g, int b, LAS char* lds) {
    const KA p = get_ka();
    const int tid = tidx();
    const int sr = stage_row(tid), sq = stage_q(tid);
    const char* U = p.ws() + OFF_USSM;
    float* E = (float*)(p.ws() + OFF_CQ) + (size_t)(g * 1024 + b * 128) * 128;
    bf16_t* SP = (bf16_t*)(p.ws() + OFF_SPREV) + (size_t)(g * 1024 + b * 128) * 256;
    SsmAF af; af.n1 = 8; af.ub = U + ((size_t)g * T_ + (size_t)b * 4096) * 32; af.sb = (const char*)SP;
#pragma unroll
    for (int i = 0; i < 4; ++i) {
        const int row = sr + 32 * i;
        af.pu[i] = (unsigned)(row * 1024 + sq * 16);
        af.ps[i] = (unsigned)(row * 256 + sq * 8) * 2u;
    }
    {
        f32x4 acc[4][4]; zero_acc<4>(acc);
        const RowsF<4> bf = mk_rows<4>(p.ws() + OFF_SG + (size_t)g * 128 * 512 * 2, 1024, 0);
        gemm_core<128>(acc, 8, af, bf, lds);
        EPI_VARS(128)
#pragma unroll
        for (int m = 0; m < 4; ++m)
#pragma unroll
            for (int n = 0; n < 4; ++n) *(f32x4*)(E + (size_t)EPI_ROW(128, m) * 128 + EPI_COL(n)) = acc[m][n];
    }
    __syncthreads();
    if (tid < 64) {
        const float2 lam = ((const float2*)(p.ws() + OFF_LAML))[g * 64 + tid];
        float sre = 0.f, sim = 0.f;
#pragma unroll 1
        for (int c0 = 0; c0 < 128; c0 += 16) {
            float er[16], ei[16];
#pragma unroll
            for (int k = 0; k < 16; ++k) { er[k] = E[(c0 + k) * 128 + tid]; ei[k] = E[(c0 + k) * 128 + 64 + tid]; }
#pragma unroll
            for (int k = 0; k < 16; ++k) {
                const int c = c0 + k;
                const bf16_t hr = f2bf(sre), hi = f2bf(sim);
                SP[c * 256 + tid] = hr; SP[c * 256 + 64 + tid] = hi;
                SP[c * 256 + 128 + tid] = f2bf(sre - bf2f(hr)); SP[c * 256 + 192 + tid] = f2bf(sim - bf2f(hi));
                const float nr = lam.x * sre - lam.y * sim + er[k], ni = lam.x * sim + lam.y * sre + ei[k];
                sre = nr; sim = ni;
            }
        }
    }
    __syncthreads();
    const float* dsk = (const float*)p.in(13) + l * 512 + g * 16;
    unsigned char* GY = (unsigned char*)(p.ws() + OFF_GC) + (size_t)g * T_ * 16;
    int cbuf = 0;
    for (int nt = 0; nt < 4; ++nt) {
        f32x4 acc[4][4]; zero_acc<4>(acc);
        af.n1 = 2 * (nt + 1);
        SsmBF bf; bf.n1 = af.n1; bf.bb = p.ws() + OFF_SBT + (size_t)(g * 512 + nt * 128) * 768 * 2;
#pragma unroll
        for (int i = 0; i < 4; ++i) bf.pb[i] = (unsigned)((sr + 32 * i) * 768 + sq * 8) * 2u;
        NextT<SsmAF, SsmBF> nx; nx.valid = nt < 3; nx.lds = lds; nx.a = af; nx.a.n1 = af.n1 + 2; nx.b = bf; nx.b.n1 = af.n1 + 2; nx.b.bb = bf.bb + (size_t)128 * 768 * 2;
        gemm_core<128>(acc, af.n1 + 4, af, bf, lds, cbuf, nt > 0, nx);
        EPI_VARS(128)
#pragma unroll
        for (int m = 0; m < 4; ++m) {
            const int c = EPI_ROW(128, m);
#pragma unroll
            for (int n = 0; n < 4; ++n) {
                const int col = nt * 128 + EPI_COL(n), i = col >> 4, pp = col & 15;
                const size_t tok = (size_t)b * 4096 + c * 32 + i;
                const f32x4 u = ld_bf4((const bf16_t*)U + ((size_t)g * T_ + tok) * 16 + pp);
                const f32x4 d = *(const f32x4*)(dsk + pp);
                const f32x4 y = acc[m][n] + d * u;
                *(unsigned*)(GY + tok * 16 + pp) = pk4_fp8(clamp8(gelu_tanh(y[0]) * GY8_SCALE), clamp8(gelu_tanh(y[1]) * GY8_SCALE), clamp8(gelu_tanh(y[2]) * GY8_SCALE), clamp8(gelu_tanh(y[3]) * GY8_SCALE));
            }
        }
    }
}
DEV void phase_c(int l, unsigned* qbase, LAS char* lds) {
    LAS int* slot = (LAS int*)(lds + LDS_WORK);
    const int x0 = (int)((unsigned)__builtin_amdgcn_s_getreg((3 << 11) | 20) & 7u);
#pragma unroll 1
    for (int k = 0; k < 8; ++k) {
        const int x = (x0 + k) & 7;
        unsigned* qctr = qbase + 64 * x;
        for (;;) {
            const int it = next_item(qctr, slot);
            if (it >= 32 + 256 * 2) break;
            if (it < 32) ssm_item(l, 4 * x + (it >> 3), it & 7, lds);
            else {
                const int j = it - 32, idx = j >> 1;
                if ((j & 1) == 0) { const int rem = idx & 63, qb = 31 - (rem >> 1), h = (idx >> 6) * 2 + (rem & 1); attn_item(x, h, qb, lds); }
                else { const int bq = x * 256 + idx, g3 = (bq >> 1) * 3; if ((bq & 1) == 0) { cvt_expert_item(l, g3, lds); cvt_expert_item(l, g3 + 1, lds); } else cvt_expert_item(l, g3 + 2, lds);
                       if (l == 0) { cvt_deferred_item(bq, lds); cvt_deferred_item(bq + 2048, lds); cvt_deferred_item(bq + 4096, lds); } }
            }
        }
    }
}

DEV void conv8_pass() {
    const KA p = get_ka();
    const bf16_t* gb = (const bf16_t*)(p.ws() + OFF_GB); unsigned char* c8 = (unsigned char*)(p.ws() + OFF_E);
    for (size_t i = (size_t)blockIdx.x * 256 + tidx(); i < (size_t)T_ * 512 / 16; i += (size_t)gridDim.x * 256) {
        const u32x4 a = *(const u32x4*)(gb + i * 16), b = *(const u32x4*)(gb + i * 16 + 8);
        u32x4 o;
        o.x = pk4_fp8(clamp8(bflo(a.x) * 2.f), clamp8(bfhi(a.x) * 2.f), clamp8(bflo(a.y) * 2.f), clamp8(bfhi(a.y) * 2.f));
        o.y = pk4_fp8(clamp8(bflo(a.z) * 2.f), clamp8(bfhi(a.z) * 2.f), clamp8(bflo(a.w) * 2.f), clamp8(bfhi(a.w) * 2.f));
        o.z = pk4_fp8(clamp8(bflo(b.x) * 2.f), clamp8(bfhi(b.x) * 2.f), clamp8(bflo(b.y) * 2.f), clamp8(bfhi(b.y) * 2.f));
        o.w = pk4_fp8(clamp8(bflo(b.z) * 2.f), clamp8(bfhi(b.z) * 2.f), clamp8(bflo(b.w) * 2.f), clamp8(bfhi(b.w) * 2.f));
        *(u32x4*)(c8 + i * 16) = o;
    }
}
struct GyAF { const char* base; unsigned off[4];
    DEV const char* operator()(int step, int i) const { return base + (off[i] + (unsigned)step * (unsigned)(8 * T_ * 16)); } };
struct NextGy {
    const char* abase; const void* bbase; int mt, brow0; bool valid; LAS char* lds;
    DEV bool operator()(int step, int buf) const {
        if (valid) {
            GyAF a; const int _t = tidx(); const int r = stage_row(_t), q = stage_q(_t); a.base = abase + (size_t)mt * 128 * 16;
#pragma unroll
            for (int i = 0; i < 4; ++i) a.off[i] = (unsigned)(r + 32 * i) * 16u + (unsigned)q * (unsigned)(T_ * 16);
            stage_tile<128>(a, mk_rows<4>(bbase, 512, brow0), step, lds, buf);
        }
        return valid;
    }
};
DEV void pd1_tile(int l, int it, int nxt, LAS char* lds, int& buf, bool primed) {
    const KA p = get_ka();
    const char* wl = p.ws() + OFF_W + (size_t)l * W_LAYER;
    const int mt = it >> 3, nt = it & 7;
    f32x4 acc[4][4]; zero_acc<4>(acc);
    GyAF af; { const int _t = tidx(); const int r = stage_row(_t), q = stage_q(_t); af.base = p.ws() + OFF_GC + (size_t)mt * 128 * 16;
#pragma unroll
        for (int i = 0; i < 4; ++i) af.off[i] = (unsigned)(r + 32 * i) * 16u + (unsigned)q * (unsigned)(T_ * 16); }
    const RowsF<4> bf = mk_rows<4>(wl + W_GLU, 512, nt * 128);
    NextGy nx; nx.valid = nxt >= 0; nx.lds = lds; nx.abase = p.ws() + OFF_GC; nx.bbase = wl + W_GLU;
    { const int i2 = nxt >= 0 ? nxt : it; nx.mt = i2 >> 3; nx.brow0 = (i2 & 7) * 128; }
    gemm_core_f8<128>(acc, 4, af, bf, lds, buf, primed, nx);
    EPI_VARS(128)
    unsigned char* GO = (unsigned char*)(p.ws() + OFF_USSM);
#pragma unroll
    for (int m = 0; m < 4; ++m) {
        const int row = mt * 128 + EPI_ROW(128, m);
#pragma unroll
        for (int n = 0; n < 2; ++n) {
            const f32x4 v = acc[m][n] * (8.f / (GY8_SCALE * WL8_SCALE)), gte = acc[m][n + 2] * (1.f / (GY8_SCALE * WL8_SCALE));
            const int col = nt * 64 + _wc * 32 + n * 16 + _fq * 4;
            *(unsigned*)(GO + (size_t)row * 512 + col) = pk4_fp8(clamp8(v[0] * sigmoidf_(gte[0])), clamp8(v[1] * sigmoidf_(gte[1])), clamp8(v[2] * sigmoidf_(gte[2])), clamp8(v[3] * sigmoidf_(gte[3])));
        }
    }
}
DEV void pd2_tile(int l, int it, int nxt, LAS char* lds, int& buf, bool primed) {
    const KA p = get_ka();
    const char* wl = p.ws() + OFF_W + (size_t)l * W_LAYER;
    const int mt = it >> 3, nt = it & 7;
    u32x2 mgp[4][4];
#pragma unroll
    for (int m = 0; m < 4; ++m)
#pragma unroll
        for (int n = 0; n < 4; ++n) mgp[m][n] = (u32x2){0u, 0u};
#pragma unroll 1
    for (int br = 0; br < 3; ++br) {
        u32x2 sp[4][4];
        const void* abase = br == 0 ? (const void*)(p.ws() + OFF_H) : br == 1 ? (const void*)(p.ws() + OFF_USSM) : (const void*)(p.ws() + OFF_XC);
        const void* bbase = wl + W_UPC + (size_t)br * 1024 * 512 * 2;
        const float ysc = 1.f / (WU8_SCALE * (br == 0 ? 2.f : br == 1 ? 8.f : 16.f));
        {
            f32x4 acc[4][4]; zero_acc<4>(acc);
            const RowsF<4> ah = mk_rows<4>(p.ws() + OFF_H8, 1024, mt * 128);
            const RowsF<4> bg = mk_rows<4>(wl + W_G, 1024, br * 1024 + nt * 128);
            NextRows nx; nx.valid = true; nx.lds = lds; nx.abase = abase; nx.apitch = 512; nx.arow0 = mt * 128; nx.bbase = bbase; nx.bpitch = 512; nx.brow0 = nt * 128;
            gemm_core_f8<128>(acc, 8, ah, bg, lds, buf, primed, nx);
#pragma unroll
            for (int m = 0; m < 4; ++m)
#pragma unroll
                for (int n = 0; n < 4; ++n) {
                    const f32x4 g = acc[m][n] * (1.f / (H8_SCALE * WG8_SCALE));
                    sp[m][n].x = pk2(sigmoidf_(g[0]), sigmoidf_(g[1])); sp[m][n].y = pk2(sigmoidf_(g[2]), sigmoidf_(g[3]));
                }
        }
        {
            f32x4 acc[4][4]; zero_acc<4>(acc);
            NextRows nx; nx.lds = lds;
            {
                const int b2 = br < 2 ? br + 1 : 0, i2 = br < 2 ? it : (nxt >= 0 ? nxt : it), m2 = i2 >> 3, n2 = i2 & 7;
                nx.valid = br < 2 || nxt >= 0;
                nx.abase = p.ws() + OFF_H8; nx.apitch = 1024; nx.arow0 = m2 * 128; nx.bbase = wl + W_G; nx.bpitch = 1024; nx.brow0 = b2 * 1024 + n2 * 128;
            }
            const RowsF<4> ay = mk_rows<4>(abase, 512, mt * 128);
            const RowsF<4> by = mk_rows<4>(bbase, 512, nt * 128);
            gemm_core_f8<128>(acc, 4, ay, by, lds, buf, true, nx);
#pragma unroll
            for (int m = 0; m < 4; ++m)
#pragma unroll
                for (int n = 0; n < 4; ++n) {
                    const f32x4 sg = (f32x4){bflo(sp[m][n].x), bfhi(sp[m][n].x), bflo(sp[m][n].y), bfhi(sp[m][n].y)};
                    const f32x4 mo = (f32x4){bflo(mgp[m][n].x), bfhi(mgp[m][n].x), bflo(mgp[m][n].y), bfhi(mgp[m][n].y)} + sg * acc[m][n] * ysc;
                    mgp[m][n].x = pk2(mo[0], mo[1]); mgp[m][n].y = pk2(mo[2], mo[3]);
                }
        }
        primed = true;
    }
    EPI_VARS(128)
    bf16_t* MG = (bf16_t*)(p.ws() + OFF_MERGED);
#pragma unroll
    for (int m = 0; m < 4; ++m)
#pragma unroll
        for (int n = 0; n < 4; ++n) {
            *(unsigned*)((unsigned char*)MG + (size_t)(mt * 128 + EPI_ROW(128, m)) * 1024 + nt * 128 + EPI_COL(n)) = pk4_fp8(clamp8(bflo(mgp[m][n].x) * MG8_SCALE), clamp8(bfhi(mgp[m][n].x) * MG8_SCALE), clamp8(bflo(mgp[m][n].y) * MG8_SCALE), clamp8(bfhi(mgp[m][n].y) * MG8_SCALE));
        }
}
DEV void pd3a_tile(int l, int it, int nxt, LAS char* lds, int& buf, bool primed) {
    const KA p = get_ka();
    const char* wl = p.ws() + OFF_W + (size_t)l * W_LAYER;
    const int mt = it >> 3, nt = it & 7;
    f32x4 acc[4][4]; zero_acc<4>(acc);
    const RowsF<4> af = mk_rows<4>(p.ws() + OFF_MERGED, 1024, mt * 128);
    const RowsF<4> bf = mk_rows<4>(wl + W_O, 1024, nt * 128);
    NextRows nx; nx.valid = nxt >= 0; nx.lds = lds;
    { const int i2 = nxt >= 0 ? nxt : it; nx.abase = p.ws() + OFF_MERGED; nx.apitch = 1024; nx.arow0 = (i2 >> 3) * 128; nx.bbase = wl + W_O; nx.bpitch = 1024; nx.brow0 = (i2 & 7) * 128; }
    gemm_core_f8<128>(acc, 8, af, bf, lds, buf, primed, nx);
    EPI_VARS(128)
    bf16_t* Y = (bf16_t*)(p.ws() + OFF_XC);
#pragma unroll
    for (int m = 0; m < 4; ++m)
#pragma unroll
        for (int n = 0; n < 4; ++n) st_bf4(Y + (size_t)(mt * 128 + EPI_ROW(128, m)) * 1024 + nt * 128 + EPI_COL(n), acc[m][n] * (1.f / (MG8_SCALE * WO8_SCALE)));
}
DEV void pd3b_item(int l, int st, LAS char* lds) {
    const KA p = get_ka();
    const int tid = tidx(), lane = tid & 63, wid = tid >> 6;
    const int row0 = st * 64, b = row0 >> 12;
    const float* ada = (const float*)(p.ws() + OFF_ADA) + ((size_t)l * 8 + b) * 6144;
    float* xout = p.out();
    {
        bf16_t* H = (bf16_t*)(p.ws() + OFF_H);
        f32x4 g[4], bb[4], sc[4], sh[4], g1[4];
        ld_vec16((const float*)p.in(25) + (l * 2 + 0) * 1024, lane, g); ld_vec16((const float*)p.in(26) + (l * 2 + 0) * 1024, lane, bb);
        ld_vec16(ada + 3072, lane, sh); ld_vec16(ada + 4096, lane, sc); ld_vec16(ada + 2048, lane, g1);
        const float* xin = l == 0 ? (const float*)p.in(0) : (const float*)p.out();
        const bf16_t* Y = (const bf16_t*)(p.ws() + OFF_XC);
        const int r0 = row0 + wid * 16;
        f32x4 xv[4]; u32x2 yv[4];
#define P3_LOAD(row) do { _Pragma("unroll") for (int j = 0; j < 4; ++j) { const int col = 4 * lane + 256 * j; \
            xv[j] = *(const f32x4*)(xin + (size_t)(row) * 1024 + col); yv[j] = *(const u32x2*)(Y + (size_t)(row) * 1024 + col); } } while (0)
        P3_LOAD(r0);
        for (int k = 0; k < 16; ++k) {
            const int row = r0 + k;
            f32x4 v[4];
#pragma unroll
            for (int j = 0; j < 4; ++j) v[j] = xv[j] * ALPHA_ + g1[j] * (f32x4){bflo(yv[j].x), bfhi(yv[j].x), bflo(yv[j].y), bfhi(yv[j].y)};
            if (k + 1 < 16) P3_LOAD(row + 1);
            ln_row<true, true>(v, lane, g, bb, xout + (size_t)row * 1024, sc, sh, H + (size_t)row * 1024, (unsigned char*)(p.ws() + OFF_H8) + (size_t)row * 1024);
        }
#undef P3_LOAD
    }
    __syncthreads();
    {
        f32x4 acc[2][4]; zero_acc<2>(acc);
        const RowsF<2> ah = mk_rows<2>(p.ws() + OFF_H, 2048, row0);
        const RowsF<4> bf = mk_rows<4>(p.ws() + OFF_WR, 4096, 0);
        gemm_core<64>(acc, 16, ah, bf, lds);
        LAS float* lg = (LAS float*)lds;
        EPI_VARS(64)
        if (_wc == 0) {
#pragma unroll
            for (int m = 0; m < 2; ++m)
#pragma unroll
                for (int n = 0; n < 2; ++n)
#pragma unroll
                    for (int j = 0; j < 4; ++j) lg[EPI_ROW(64, m) * 33 + n * 16 + _fq * 4 + j] = acc[m][n][j] + acc[m][n + 2][j];
        }
        __syncthreads();
        if (tid < 64) {
            const float* rb = (const float*)p.in(28);
            float sc[32], sel[32];
#pragma unroll
            for (int e = 0; e < 32; ++e) { sc[e] = sigmoidf_(lg[tid * 33 + e]); sel[e] = sc[e] + rb[e]; }
            int bg = 0; float bgs = -INFINITY;
#pragma unroll
            for (int g = 0; g < 8; ++g) {
                float m1 = -INFINITY, m2 = -INFINITY;
#pragma unroll
                for (int j = 0; j < 4; ++j) { const float v = sel[g * 4 + j]; if (v > m1) { m2 = m1; m1 = v; } else if (v > m2) m2 = v; }
                const float gs = m1 + m2;
                if (gs > bgs) { bgs = gs; bg = g; }
            }
            int e1 = 0, e2 = 0; float v1 = -INFINITY, v2 = -INFINITY, s1 = 0.f, s2 = 0.f;
#pragma unroll
            for (int g = 0; g < 8; ++g) if (g == bg) {
#pragma unroll
                for (int j = 0; j < 4; ++j) { const float v = sel[g * 4 + j], s = sc[g * 4 + j];
                    if (v > v1) { v2 = v1; e2 = e1; s2 = s1; v1 = v; e1 = g * 4 + j; s1 = s; } else if (v > v2) { v2 = v; e2 = g * 4 + j; s2 = s; } }
            }
            const int tok = row0 + tid; const float inv = 1.f / (s1 + s2);
            float* rw = (float*)(p.ws() + OFF_RW); rw[tok * 2] = s1 * inv; rw[tok * 2 + 1] = s2 * inv;
            ((unsigned*)(p.ws() + OFF_ROUTE))[tok] = (unsigned)e1 | ((unsigned)e2 << 8);
        }
        __syncthreads();
    }
}

DEV void pd4_item(int l, int e, LAS char* lds) {
    const KA p = get_ka();
    const int tid = tidx(), lane = tid & 63, w = tid >> 6;
    LAS int* wcnt = (LAS int*)lds;
    const unsigned* route = (const unsigned*)(p.ws() + OFF_ROUTE) + w * 8192 + lane * 4;
    unsigned* list = (unsigned*)(p.ws() + OFF_LIST) + (size_t)e * T_;
    int c = 0;
#pragma unroll 1
    for (int i0 = 0; i0 < 32; i0 += 8) {
        u32x4 rv[8];
#pragma unroll
        for (int k = 0; k < 8; ++k) rv[k] = *(const u32x4*)(route + (i0 + k) * 256);
#pragma unroll
        for (int k = 0; k < 8; ++k) {
            const unsigned rr[4] = {rv[k].x, rv[k].y, rv[k].z, rv[k].w};
#pragma unroll
            for (int j = 0; j < 4; ++j) c += ((int)(rr[j] & 255u) == e || (int)((rr[j] >> 8) & 255u) == e) ? 1 : 0;
        }
    }
    c = (int)wave_sum((float)c);
    __syncthreads();
    if (lane == 0) wcnt[w] = c;
    __syncthreads();
    int off = 0, total = 0;
    for (int k = 0; k < 4; ++k) { const int v = wcnt[k]; if (k < w) off += v; total += v; }
    if (tid == 0) ((unsigned*)(p.ws() + OFF_CTRL))[CW_CNT + (l * 32 + e) * 32] = (unsigned)total;
#pragma unroll 1
    for (int i0 = 0; i0 < 32; i0 += 8) {
        u32x4 rv[8];
#pragma unroll
        for (int k = 0; k < 8; ++k) rv[k] = *(const u32x4*)(route + (i0 + k) * 256);
#pragma unroll
        for (int k = 0; k < 8; ++k) {
            const int it = i0 + k;
            const unsigned rr[4] = {rv[k].x, rv[k].y, rv[k].z, rv[k].w};
#pragma unroll
            for (int j = 0; j < 4; ++j) {
                const int m0 = (int)(rr[j] & 255u) == e, m1 = (int)((rr[j] >> 8) & 255u) == e;
                const unsigned long long bal = __ballot(m0 || m1);
                const int rank = __popcll(bal & ((1ull << lane) - 1ull));
                if (m0 || m1) list[off + rank] = (unsigned)(w * 8192 + it * 256 + lane * 4 + j) * 2u + (m1 ? 1u : 0u);
                off += __popcll(bal);
            }
        }
    }
    __syncthreads();
}

constexpr int RB_ = 160;
struct NextPe {
    const RowsF<RB_ / 32>* a; const void* bbase; unsigned bpitch; int brow0; bool valid; LAS char* lds;
    DEV bool operator()(int step, int buf) const { if (valid) stage_tile<RB_>(*a, mk_rows<4>(bbase, bpitch, brow0), step, lds, buf); return valid; }
};
DEV void pe_item(int l, int e, int rb, int padrow0, int count, LAS char* lds) {
    const KA p = get_ka();
    const int tid = tidx(); const int sr = stage_row(tid), sq = stage_q(tid);
    const unsigned* list = (const unsigned*)(p.ws() + OFF_LIST) + (size_t)e * T_ + rb * RB_;
    const int nvalid = min(RB_, count - rb * RB_);
    const char* w13 = p.ws() + OFF_E13 + (size_t)e * 512 * 1024;
    const char* w2 = p.ws() + OFF_E2 + (size_t)e * 1024 * 256;
    unsigned char* mid = (unsigned char*)(p.ws() + OFF_MIDR) + (size_t)padrow0 * 256;
    RowsF<5> ah; ah.base = p.ws() + OFF_H8;
#pragma unroll
    for (int i = 0; i < 5; ++i) {
        const int row = sr + 32 * i;
        const int tok = (int)(list[row < nvalid ? row : 0] >> 1);
        ah.off[i] = (unsigned)tok * 1024u + sq * 16;
    }
    int cbuf = 0;
#pragma unroll 1
    for (int nt = 0; nt < 4; ++nt) {
        f32x4 acc[5][4]; zero_acc<5>(acc);
        const RowsF<4> bf = mk_rows<4>(w13, 1024, nt * 128);
        NextPe nx; nx.valid = nt < 3; nx.lds = lds; nx.a = &ah; nx.bbase = w13; nx.bpitch = 1024; nx.brow0 = (nt < 3 ? nt + 1 : nt) * 128;
        gemm_core_f8<RB_>(acc, 8, ah, bf, lds, cbuf, nt > 0, nx);
        EPI_VARS(RB_)
        constexpr float s1 = 1.f / (H8_SCALE * WE8_SCALE);
#pragma unroll
        for (int m = 0; m < 5; ++m) {
            const int row = EPI_ROW(RB_, m);
#pragma unroll
            for (int n = 0; n < 2; ++n) {
                const f32x4 a = acc[m][n] * s1, g = acc[m][n + 2] * (s1 * MID8_SCALE);
                const int col = nt * 64 + _wc * 32 + n * 16 + _fq * 4;
                *(unsigned*)(mid + (size_t)row * 256 + col) = pk4_fp8(clamp8(siluf_(a[0]) * g[0]), clamp8(siluf_(a[1]) * g[1]), clamp8(siluf_(a[2]) * g[2]), clamp8(siluf_(a[3]) * g[3]));
            }
        }
    }
    __syncthreads();
    const RowsF<5> am = mk_rows<5>(mid, 256, 0);
    const float* rw = (const float*)(p.ws() + OFF_RW);
    EPI_VARS(RB_)
    unsigned orow[5]; float ow[5];
#pragma unroll
    for (int m = 0; m < 5; ++m) {
        const int row = EPI_ROW(RB_, m);
        if (row < nvalid) { const unsigned en = list[row]; orow[m] = en; ow[m] = rw[en] * (1.f / (MID8_SCALE * WE8_SCALE)); }
        else { orow[m] = 0u; ow[m] = 0.f; }
    }
    bf16_t* outb = (bf16_t*)(p.ws() + OFF_ROUT);
    cbuf = 0;
#pragma unroll 1
    for (int nt = 0; nt < 8; ++nt) {
        f32x4 acc[5][4]; zero_acc<5>(acc);
        const RowsF<4> bf = mk_rows<4>(w2, 256, nt * 128);
        NextPe nx; nx.valid = nt < 7; nx.lds = lds; nx.a = &am; nx.bbase = w2; nx.bpitch = 256; nx.brow0 = (nt < 7 ? nt + 1 : nt) * 128;
        gemm_core_f8<RB_>(acc, 2, am, bf, lds, cbuf, nt > 0, nx);
#pragma unroll
        for (int m = 0; m < 5; ++m) {
            if (EPI_ROW(RB_, m) < nvalid) {
#pragma unroll
                for (int n = 0; n < 4; ++n) st_bf4(outb + (size_t)orow[m] * 1024 + nt * 128 + EPI_COL(n), acc[m][n] * ow[m]);
            }
        }
    }
}
DEV void shared_g1_tile(int l, int it, int nxt, LAS char* lds, int& buf, bool primed) {
    const KA p = get_ka();
    const char* wl = p.ws() + OFF_W + (size_t)l * W_LAYER;
    const int mt = it >> 2, nt = it & 3;
    f32x4 acc[4][4]; zero_acc<4>(acc);
    const RowsF<4> af = mk_rows<4>(p.ws() + OFF_H8, 1024, mt * 128);
    const RowsF<4> bf = mk_rows<4>(wl + W_S13, 1024, nt * 128);
    NextRows nx; nx.valid = nxt >= 0; nx.lds = lds; nx.abase = p.ws() + OFF_H8; nx.apitch = 1024; nx.bbase = wl + W_S13; nx.bpitch = 1024;
    { const int i2 = nxt >= 0 ? nxt : it; nx.arow0 = (i2 >> 2) * 128; nx.brow0 = (i2 & 3) * 128; }
    gemm_core_f8<128>(acc, 8, af, bf, lds, buf, primed, nx);
    EPI_VARS(128)
    unsigned char* mid = (unsigned char*)(p.ws() + OFF_MIDS) + (size_t)mt * 128 * 256;
    constexpr float s1 = 1.f / (H8_SCALE * WE8_SCALE);
#pragma unroll
    for (int m = 0; m < 4; ++m) {
        const int row = EPI_ROW(128, m);
#pragma unroll
        for (int n = 0; n < 2; ++n) {
            const f32x4 a = acc[m][n] * s1, g = acc[m][n + 2] * (s1 * MID8_SCALE);
            const int col = nt * 64 + _wc * 32 + n * 16 + _fq * 4;
            *(unsigned*)(mid + (size_t)row * 256 + col) = pk4_fp8(clamp8(siluf_(a[0]) * g[0]), clamp8(siluf_(a[1]) * g[1]), clamp8(siluf_(a[2]) * g[2]), clamp8(siluf_(a[3]) * g[3]));
        }
    }
}
DEV void shared_g2_item(int l, int mt, int quarter, LAS char* lds) {
    const KA p = get_ka();
    const char* wl = p.ws() + OFF_W + (size_t)l * W_LAYER;
    const RowsF<4> am = mk_rows<4>(p.ws() + OFF_MIDS, 256, mt * 128);
    bf16_t* outb = (bf16_t*)(p.ws() + OFF_SHOUT) + (size_t)mt * 128 * 1024;
    int cbuf = 0;
#pragma unroll 1
    for (int nt = 2 * quarter; nt < 2 * quarter + 2; ++nt) {
        f32x4 acc[4][4]; zero_acc<4>(acc);
        const bool more = nt < 2 * quarter + 1;
        const RowsF<4> bf = mk_rows<4>(wl + W_S2, 256, nt * 128);
        NextRows nx; nx.valid = more; nx.lds = lds; nx.abase = p.ws() + OFF_MIDS; nx.apitch = 256; nx.arow0 = mt * 128; nx.bbase = wl + W_S2; nx.bpitch = 256; nx.brow0 = (more ? nt + 1 : nt) * 128;
        gemm_core_f8<128>(acc, 2, am, bf, lds, cbuf, nt > 2 * quarter, nx);
        EPI_VARS(128)
#pragma unroll
        for (int m = 0; m < 4; ++m)
#pragma unroll
            for (int n = 0; n < 4; ++n) st_bf4(outb + (size_t)EPI_ROW(128, m) * 1024 + nt * 128 + EPI_COL(n), acc[m][n] * (1.f / (MID8_SCALE * WE8_SCALE)));
    }
}
DEV void phase_e(int l, unsigned* qctr, LAS char* lds) {
    const KA p = get_ka();
    LAS int* slot = (LAS int*)(lds + LDS_WORK);
    LAS int* pre = slot + 4;
    const int tid = tidx();
    const unsigned* cnt = (const unsigned*)(p.ws() + OFF_CTRL) + CW_CNT + l * 32 * 32;
    if (tid < 32) pre[40 + tid] = (int)cnt[tid * 32];
    __syncthreads();
    if (tid == 0) { int a = 0; for (int e = 0; e < 32; ++e) { const int c = pre[40 + e]; pre[e] = a; a += (c + RB_ - 1) / RB_; } pre[32] = a; }
    __syncthreads();
    const int nrb = pre[32];
    const int npre = (l + 1 < NL_) ? 128 : 0;
    const int nstatic = nrb < (int)gridDim.x ? nrb : (int)gridDim.x;
    {
        const int it = vblock();
        if (it < nstatic) {
            int e = 0;
            for (int k = 0; k < 32; ++k) if (it >= pre[k + 1]) e = k + 1;
            pe_item(l, e, it - pre[e], it * RB_, pre[40 + e], lds);
        }
    }
    for (;;) {
        int it = next_item(qctr, slot) + nstatic;
        if (it >= nrb + npre + 1024) break;
        if (it < nrb) {
            int e = 0;
            for (int k = 0; k < 32; ++k) if (it >= pre[k + 1]) e = k + 1;
            pe_item(l, e, it - pre[e], it * RB_, pre[40 + e], lds);
            continue;
        }
        it -= nrb;
        if (it < npre) { ssm_pre_item(l + 1, it, lds); continue; }
        shared_g2_item(l, (it - npre) >> 2, (it - npre) & 3, lds);
    }
}

DEV void phase_f(int l) {
    const KA p = get_ka();
    const int lane = tidx() & 63, gw = blockIdx.x * 4 + (tidx() >> 6), ngw = gridDim.x * 4;
    const bf16_t* R = (const bf16_t*)(p.ws() + OFF_ROUT); const bf16_t* SH = (const bf16_t*)(p.ws() + OFF_SHOUT);
    bf16_t* H = (bf16_t*)(p.ws() + OFF_H);
    const int rpw = T_ / ngw;
    if (rpw * ngw != T_ || (4096 % rpw) != 0) return;
    const int r0 = gw * rpw, b = r0 >> 12;
    const float* ada = (const float*)(p.ws() + OFF_ADA) + ((size_t)l * 8 + b) * 6144;
    f32x4 g[4], bb[4], sc[4], sh[4], g2[4];
    ld_vec16((const float*)p.in(25) + (l * 2 + 1) * 1024, lane, g); ld_vec16((const float*)p.in(26) + (l * 2 + 1) * 1024, lane, bb);
    ld_vec16(ada + 5120, lane, g2);
    if (l + 1 < NL_) { const float* ada2 = (const float*)(p.ws() + OFF_ADA) + ((size_t)(l + 1) * 8 + b) * 6144; ld_vec16(ada2 + 0, lane, sh); ld_vec16(ada2 + 1024, lane, sc); }
    else {
#pragma unroll
        for (int j = 0; j < 4; ++j) { sh[j] = (f32x4){0.f, 0.f, 0.f, 0.f}; sc[j] = sh[j]; }
    }
    u32x2 ra[4], rb[4], rs[4]; f32x4 xv[4];
#define PF_LOAD(row) do { _Pragma("unroll") for (int j = 0; j < 4; ++j) { const int col = 4 * lane + 256 * j; \
        ra[j] = *(const u32x2*)(R + (size_t)(row) * 2048 + col); rb[j] = *(const u32x2*)(R + (size_t)(row) * 2048 + 1024 + col); rs[j] = *(const u32x2*)(SH + (size_t)(row) * 1024 + col); \
        xv[j] = *(const f32x4*)(p.out() + (size_t)(row) * 1024 + col); } } while (0)
    PF_LOAD(r0);
    for (int k = 0; k < rpw; ++k) {
        const int row = r0 + k;
        f32x4 v[4];
#pragma unroll
        for (int j = 0; j < 4; ++j) {
            const f32x4 y = (f32x4){bflo(ra[j].x) + bflo(rb[j].x) + bflo(rs[j].x), bfhi(ra[j].x) + bfhi(rb[j].x) + bfhi(rs[j].x), bflo(ra[j].y) + bflo(rb[j].y) + bflo(rs[j].y), bfhi(ra[j].y) + bfhi(rb[j].y) + bfhi(rs[j].y)};
            v[j] = xv[j] * ALPHA_ + g2[j] * y;
        }
        if (k + 1 < rpw) PF_LOAD(row + 1);
        if (l + 1 < NL_) ln_row<true, true>(v, lane, g, bb, p.out() + (size_t)row * 1024, sc, sh, nullptr, (unsigned char*)(p.ws() + OFF_H8) + (size_t)row * 1024);
        else ln_row<true, false>(v, lane, g, bb, p.out() + (size_t)row * 1024, sc, sh, nullptr);
    }
#undef PF_LOAD
}

#define XB_TMO      128
#define XB_XCNT(j)  (256  + 64 * (j))
#define XB_XSUB(j)  (1280 + 64 * (j))
#define XB_XGEN(j)  (2304 + 64 * (j))
#define XB_TOP      3328
#define XB_TOPGEN   3392
#define XCD_BAR_WORDS 3456
#define XB_SPIN_CAP (1u << 18)
DEV unsigned xb_ld(unsigned* p)              { return __hip_atomic_load(p, __ATOMIC_RELAXED, __HIP_MEMORY_SCOPE_AGENT); }
DEV unsigned xb_add(unsigned* p, unsigned v) { return __hip_atomic_fetch_add(p, v, __ATOMIC_RELAXED, __HIP_MEMORY_SCOPE_AGENT); }
DEV unsigned xb_xcc_id() { return (unsigned)__builtin_amdgcn_s_getreg((3 << 11) | 20) & 0xFu; }
#define XB_SPIN(cond, bar) do { unsigned _sp = 0; while (cond) { __builtin_amdgcn_s_sleep(1); \
    if ((++_sp & 255u) == 0u) { if (xb_ld(&(bar)[XB_TMO])) break; if (_sp > XB_SPIN_CAP) { atomicAdd(&(bar)[XB_TMO], 1u); break; } } } } while (0)
struct XcdBarrier { unsigned* bar; unsigned x; volatile LAS unsigned* st; };
DEV XcdBarrier xcd_barrier_post(unsigned* bar, volatile LAS unsigned* st) {
    XcdBarrier b; b.bar = bar; b.x = xb_xcc_id(); b.st = st;
    if (tidx() == 0) (void)xb_add(&bar[XB_XCNT(b.x)], 1u);
    return b;
}
DEV void xcd_barrier_complete(unsigned* bar, unsigned x, unsigned& nloc, unsigned& nx) {
    const unsigned G = gridDim.x * gridDim.y * gridDim.z;
    unsigned sum, cnt, mine, sp = 0u;
    for (;;) {
        sum = 0u; cnt = 0u; mine = 0u;
#pragma unroll
        for (unsigned j = 0; j < 16; ++j) { const unsigned c = xb_ld(&bar[XB_XCNT(j)]); sum += c; cnt += (c > 0u) ? 1u : 0u; mine = (j == x) ? c : mine; }
        if (sum == G) break;
        __builtin_amdgcn_s_sleep(1);
        if ((++sp & 255u) == 0u) { if (xb_ld(&bar[XB_TMO])) break; if (sp > XB_SPIN_CAP) { atomicAdd(&bar[XB_TMO], 1u); break; } }
    }
    nloc = mine > 0u ? mine : 1u; nx = cnt > 0u ? cnt : 1u;
}
DEV void xcd_barrier(const XcdBarrier& b) {
    asm volatile("s_waitcnt vmcnt(0)" ::: "memory");
    __syncthreads();
    if (tidx() == 0) {
        unsigned* bar = b.bar;
        __builtin_amdgcn_s_waitcnt(0);
        unsigned nloc = b.st[0], nx = b.st[1];
        if (nloc == 0u) { xcd_barrier_complete(bar, b.x, nloc, nx); b.st[0] = nloc; b.st[1] = nx; }
        const unsigned old = xb_add(&bar[XB_XSUB(b.x)], 1u);
        const unsigned gen = old / nloc;
        if (old + 1u == (gen + 1u) * nloc) {
            __builtin_amdgcn_fence(__ATOMIC_RELEASE, "agent");
            asm volatile("s_waitcnt vmcnt(0)" ::: "memory");
            const unsigned og = xb_add(&bar[XB_TOP], 1u);
            const unsigned tg = og / nx;
            if (og + 1u == (tg + 1u) * nx) xb_add(&bar[XB_TOPGEN], 1u);
            else XB_SPIN(xb_ld(&bar[XB_TOPGEN]) == tg, bar);
            __builtin_amdgcn_fence(__ATOMIC_ACQUIRE, "agent");
            xb_add(&bar[XB_XGEN(b.x)], 1u);
            asm volatile("s_waitcnt vmcnt(0)" ::: "memory");
        } else {
            XB_SPIN(xb_ld(&bar[XB_XGEN(b.x)]) == gen, bar);
            __builtin_amdgcn_fence(__ATOMIC_ACQUIRE, "agent");
            asm volatile("s_waitcnt vmcnt(0)" ::: "memory");
        }
    }
    __syncthreads();
}

DEV void xcd_barrier_now(LAS char* lds) {
    XcdBarrier b; b.bar = (unsigned*)(get_ka().ws() + OFF_CTRL) + CW_BAR; b.x = xb_xcc_id(); b.st = (volatile LAS unsigned*)(lds + LDS_WORK + 768);
    xcd_barrier(b);
}
#ifndef DBG_STOP
#define DBG_STOP 0
#endif
#ifndef DBG_L
#define DBG_L 0
#endif
DEV void dbg_dump(size_t off) {
    const KA p = get_ka();
    const bf16_t* src = (const bf16_t*)(p.ws() + off); float* out = p.out();
    for (size_t i = (size_t)blockIdx.x * 256 + tidx(); i < (size_t)T_ * 1024 / 4; i += (size_t)gridDim.x * 256) {
        const f32x4 v = ld_bf4(src + i * 4); *(f32x4*)(out + i * 4) = v;
    }
}
#define DBG_AT(k, off) if (DBG_STOP == (k) && l == DBG_L) { dbg_dump(off); return; }
#ifndef DBG_TIME
#define DBG_TIME 0
#endif
#define TBEG(id) unsigned long long _t0 = 0; if (((DBG_TIME >> (id)) & 1) && blockIdx.x == 0) _t0 = __builtin_amdgcn_s_memrealtime();
#define TEND(id) if (((DBG_TIME >> (id)) & 1) && blockIdx.x == 0) tacc += __builtin_amdgcn_s_memrealtime() - _t0;

__global__ void __launch_bounds__(256, 2) fwd_megakernel(Params pk) {
    extern __shared__ __attribute__((aligned(16))) unsigned char smem[];
    LAS char* lds = (LAS char*)smem;
    const int nb = gridDim.x, bid = blockIdx.x;
    unsigned long long tacc = 0;
    if (get_ka().ws() == nullptr) cg::this_grid().sync();
    {
        volatile LAS unsigned* st = (volatile LAS unsigned*)(lds + LDS_WORK + 768);
        if (tidx() < 2) st[tidx()] = 0u;
        __syncthreads();
    }
    (void)xcd_barrier_post((unsigned*)(get_ka().ws() + OFF_CTRL) + CW_BAR, (volatile LAS unsigned*)(lds + LDS_WORK + 768));
    { TBEG(0)
#pragma unroll 1
      for (int it = bid; it < 512; it += nb) { if (it < 384) ada_item(it, lds); else ssm_pre_item(0, it - 384, lds); }
      phase0(lds);
      xcd_barrier_now(lds); TEND(0) }
    { TBEG(1) phase_lnmod0(); xcd_barrier_now(lds); TEND(1) }
    { const int l = 0; DBG_AT(20, OFF_H) DBG_AT(21, OFF_W) }
#pragma unroll 1
    for (int l = 0; l < NL_; ++l) {
        { TBEG(2) phase_a(l, lds); xcd_barrier_now(lds); TEND(2) }
        DBG_AT(1, OFF_XC) DBG_AT(2, OFF_GB) DBG_AT(3, OFF_CQ)
        { TBEG(3) phase_b(l, lds); xcd_barrier_now(lds); TEND(3) }
        DBG_AT(4, OFF_Q) DBG_AT(5, OFF_KN + 16 * MiB)
        { TBEG(4) phase_c(l, (unsigned*)(get_ka().ws() + OFF_CTRL) + CW_QUEUE + 64 * (8 + 8 * l), lds); xcd_barrier_now(lds); TEND(4) }
        DBG_AT(6, OFF_XC)
        { TBEG(5)
        { int buf = 0; bool primed = false;
          for (int it = vblock(); it < 2048; it += nb) { const int nxt = it + nb < 2048 ? it + nb : -1; pd1_tile(l, it, nxt, lds, buf, primed); primed = nxt >= 0; } }
        xcd_barrier_now(lds); TEND(5) }
        DBG_AT(7, OFF_GB)
        { TBEG(6)
        { int buf = 0; bool primed = false;
          for (int it = vblock(); it < 2048; it += nb) { const int nxt = it + nb < 2048 ? it + nb : -1; pd2_tile(l, it, nxt, lds, buf, primed); primed = nxt >= 0; } }
        xcd_barrier_now(lds); TEND(6) }
        DBG_AT(8, OFF_MERGED)
        { TBEG(7)
        { int buf = 0; bool primed = false;
          for (int it = vblock(); it < 2048; it += nb) { const int nxt = it + nb < 2048 ? it + nb : -1; pd3a_tile(l, it, nxt, lds, buf, primed); primed = nxt >= 0; } }
        xcd_barrier_now(lds); TEND(7) }
        { TBEG(14)
#pragma unroll 1
        for (int it = bid; it < 512; it += nb) pd3b_item(l, it, lds);
        xcd_barrier_now(lds); TEND(14) }
        DBG_AT(9, OFF_H)
        { TBEG(8)
#pragma unroll 1
        for (int it = bid; it < 32; it += nb) pd4_item(l, it, lds);
        { int buf = 0; bool primed = false;
          const int nw = nb > 64 ? nb - 32 : nb, w0 = nb > 64 ? bid - 32 : bid;
          if (w0 >= 0) for (int it = w0; it < 1024; it += nw) { const int nxt = it + nw < 1024 ? it + nw : -1; shared_g1_tile(l, it, nxt, lds, buf, primed); primed = nxt >= 0; } }
        xcd_barrier_now(lds); TEND(8) }
        { TBEG(9) phase_e(l, (unsigned*)(get_ka().ws() + OFF_CTRL) + CW_QUEUE + 64 * (2 * l + 1), lds); xcd_barrier_now(lds); TEND(9) }
        DBG_AT(11, OFF_ROUT) DBG_AT(12, OFF_SHOUT)
        { TBEG(10) phase_f(l); xcd_barrier_now(lds); TEND(10) }
    }
    if (DBG_TIME != 0 && bid == 0) {
        const unsigned long long t0 = __builtin_amdgcn_s_memrealtime();
        while (__builtin_amdgcn_s_memrealtime() - t0 < 4 * tacc) __builtin_amdgcn_s_sleep(8);
    }
}

extern "C" void kernel_launch(void* const* d_in, const int* in_sizes, int n_in, void* d_out, int out_size, void* d_ws, size_t ws_size, hipStream_t stream) {
    static int grid_blocks = 0;
    if (grid_blocks == 0) {
        if (n_in != 35 || ws_size < OFF_END) { fprintf(stderr, "kernel_launch: unexpected n_in %d or ws_size %zu (need %zu)\n", n_in, ws_size, (size_t)OFF_END); grid_blocks = -1; return; }
        int dev = 0, cus = 0, per_cu = 0;
        (void)hipGetDevice(&dev);
        (void)hipDeviceGetAttribute(&cus, hipDeviceAttributeMultiprocessorCount, dev);
        if (hipFuncSetAttribute((const void*)fwd_megakernel, hipFuncAttributeMaxDynamicSharedMemorySize, LDS_BYTES) != hipSuccess) { fprintf(stderr, "hipFuncSetAttribute failed\n"); grid_blocks = -1; return; }
        if (hipOccupancyMaxActiveBlocksPerMultiprocessor(&per_cu, (const void*)fwd_megakernel, 256, LDS_BYTES) != hipSuccess || per_cu < 1) { fprintf(stderr, "occupancy query failed\n"); grid_blocks = -1; return; }
        if (per_cu > 2) per_cu = 2;
        grid_blocks = cus * per_cu;
        fprintf(stderr, "kernel_launch: %d CUs x %d blocks\n", cus, per_cu);
    }
    if (grid_blocks < 0) return;
    (void)hipMemsetAsync((char*)d_ws + OFF_CTRL, 0, CTRL_BYTES, stream);
    Params p{};
    for (int i = 0; i < 35; ++i) p.in[i] = d_in[i];
    p.out = (float*)d_out; p.ws = (char*)d_ws;
    void* args[] = {&p};
    hipError_t e = hipLaunchCooperativeKernel((void*)fwd_megakernel, dim3(grid_blocks), dim3(256), args, LDS_BYTES, stream);
    if (e != hipSuccess) fprintf(stderr, "cooperative launch failed: %s (grid %d)\n", hipGetErrorString(e), grid_blocks);
}
```
